# Optimizing an MI355X kernel written in HIP

```python
import math
import jax, jax.numpy as jnp
from jax import lax
import numpy as np

D_MODEL = 2048
BATCH = 4
SEQ = 2048
DEPTH = 2

CTX_LEN = 256
GRID_W = 64
HEAD_DIM = 64
GROUP_WIDTH = D_MODEL // 4
A_HEADS = GROUP_WIDTH // HEAD_DIM
A_DK = HEAD_DIM
A_DV = HEAD_DIM
B_HEADS = GROUP_WIDTH // HEAD_DIM
B_DK = HEAD_DIM
B_DV = HEAD_DIM
C_DQK = HEAD_DIM
C_DV = 2 * HEAD_DIM
C_HEADS = GROUP_WIDTH // C_DV
D_WIDTH = GROUP_WIDTH
D_BLOCKS = 8
D_CONV = 4
D_CONV_LEFT = 1
RG_C = 8.0
MIX_WIDTH = A_HEADS * A_DV + B_HEADS * B_DV + C_HEADS * C_DV + D_WIDTH
IN_SIZES = (A_HEADS * A_DK, A_HEADS * A_DK, A_HEADS * A_DK, A_HEADS * A_DV, A_HEADS * A_DV,
            B_HEADS * B_DK, B_HEADS * B_DK, B_HEADS * B_DV, B_HEADS * B_DV,
            C_HEADS * 2 * C_DQK, C_HEADS * 2 * C_DQK, C_HEADS * C_DV,
            D_WIDTH, D_WIDTH)
IN_WIDTH = sum(IN_SIZES)
D_FF = ((8 * D_MODEL // 3 + 127) // 128) * 128
FFN_RESIDUAL = 0.5
N_MOD = 9
CHUNK = 16
Q_BLOCK = 128
ROPE_BASE = 10000.0
EPS = 1e-6

kernel_name = "hybrid_parallel_group_dit_trunk"


def rms_norm(t, g):
    tf = t.astype(jnp.float32)
    y = tf * lax.rsqrt(jnp.mean(tf * tf, axis=-1, keepdims=True) + EPS)
    return (y * g.astype(jnp.float32)).astype(t.dtype)


def modulate(t, shift, scale):
    return t * (1.0 + scale) + shift


def maybe_flip(t, axis, rev):
    return jnp.flip(t, axis=axis) if rev else t


def to_heads(t, h):
    b, n, _ = t.shape
    return t.reshape(b, n, h, -1).transpose(0, 2, 1, 3)


def from_heads(t):
    b, h, n, d = t.shape
    return t.transpose(0, 2, 1, 3).reshape(b, n, h * d)


def split_cols(z):
    return jnp.split(z, np.cumsum(IN_SIZES)[:-1].tolist(), axis=-1)


def axial_rope_tables(rows, head_dim):
    quarter = head_dim // 4
    inv_freq = ROPE_BASE ** (-jnp.arange(quarter, dtype=jnp.float32) / quarter)
    row = jnp.repeat(jnp.arange(rows, dtype=jnp.float32), GRID_W)
    col = jnp.tile(jnp.arange(GRID_W, dtype=jnp.float32), rows)
    ang = jnp.concatenate([row[:, None] * inv_freq, col[:, None] * inv_freq], axis=-1)
    return jnp.cos(ang), jnp.sin(ang)


def apply_rope(t, cos, sin):
    tf = t.astype(jnp.float32)
    t1, t2 = jnp.split(tf, 2, axis=-1)
    out = jnp.concatenate([t1 * cos - t2 * sin, t2 * cos + t1 * sin], axis=-1)
    return out.astype(t.dtype)


def lower_bounds_from_logits(lb_logits):
    cum = jnp.cumsum(jax.nn.softmax(lb_logits.astype(jnp.float32), axis=0), axis=0)
    return cum - cum[:1]


def gla_chunkwise(q, k, v, log_f, s0):
    out_dtype = v.dtype
    q, k, v, log_f = (t.astype(jnp.float32) for t in (q, k, v, log_f))
    b_, h, n_tok, dk = q.shape
    dv = v.shape[-1]
    n = n_tok // CHUNK
    rs = lambda t: t.reshape(b_, h, n, CHUNK, t.shape[-1])
    q, k, v, log_f = rs(q), rs(k), rs(v), rs(log_f)
    b = jnp.cumsum(log_f, axis=3)
    b_last = b[:, :, :, -1:]
    mask = jnp.tril(jnp.ones((CHUNK, CHUNK), bool))
    diff = b[:, :, :, :, None, :] - b[:, :, :, None, :, :]
    decay = jnp.exp(jnp.where(mask[:, :, None], diff, -jnp.inf))
    scores = jnp.einsum('bhnid,bhnjd,bhnijd->bhnij', q, k, decay)
    o_intra = jnp.einsum('bhnij,bhnjv->bhniv', scores, v)
    u = jnp.einsum('bhnjd,bhnjv->bhndv', k * jnp.exp(b_last - b), v)
    g = jnp.exp(b_last[:, :, :, 0])

    def step(s, xs):
        g_n, u_n = xs
        return g_n[..., None] * s + u_n, s

    s_final, s_prev = lax.scan(step, s0.astype(jnp.float32),
                               (jnp.moveaxis(g, 2, 0), jnp.moveaxis(u, 2, 0)))
    s_prev = jnp.moveaxis(s_prev, 0, 2)
    o_inter = jnp.einsum('bhnid,bhndv->bhniv', q * jnp.exp(b), s_prev)
    o = (o_intra + o_inter).reshape(b_, h, n_tok, dv)
    return o.astype(out_dtype), s_final


def bidirectional_gla(q_c, v_c, kf_c, q_x, v_x, kf_x):
    b_, h, _, dk = q_c.shape
    dv = v_c.shape[-1]
    o_c, o_x = 0.0, 0.0
    for d in range(2):
        rev = d == 1
        (k_c, lf_c), (k_x, lf_x) = kf_c[d], kf_x[d]
        s0 = jnp.zeros((b_, h, dk, dv), jnp.float32)
        oc, s_ctx = gla_chunkwise(maybe_flip(q_c, 2, rev), maybe_flip(k_c, 2, rev),
                                  maybe_flip(v_c, 2, rev), maybe_flip(lf_c, 2, rev), s0)
        ox, _ = gla_chunkwise(maybe_flip(q_x, 2, rev), maybe_flip(k_x, 2, rev),
                              maybe_flip(v_x, 2, rev), maybe_flip(lf_x, 2, rev), s_ctx)
        o_c = o_c + maybe_flip(oc, 2, rev)
        o_x = o_x + maybe_flip(ox, 2, rev)
    return o_c, o_x


def hgrn2_group(zc, zx, lower_bound, gain):
    def forget_key(zf, lb):
        lb_h = lb.astype(jnp.float32).reshape(A_HEADS, 1, A_DK)
        f = lb_h + (1.0 - lb_h) * jax.nn.sigmoid(to_heads(zf, A_HEADS).astype(jnp.float32))
        return (1.0 - f, jnp.log(f))

    def prep(z):
        zq, zff, zfb, zv, zg = z
        q = jax.nn.silu(to_heads(zq, A_HEADS))
        v = to_heads(zv, A_HEADS)
        kf = [forget_key(zff, lower_bound[0]), forget_key(zfb, lower_bound[1])]
        return q, v, kf, zg

    q_c, v_c, kf_c, g_c = prep(zc)
    q_x, v_x, kf_x, g_x = prep(zx)
    o_c, o_x = bidirectional_gla(q_c, v_c, kf_c, q_x, v_x, kf_x)
    out = lambda o, g: from_heads(rms_norm(o, gain)) * jax.nn.silu(g)
    return out(o_c, g_c), out(o_x, g_x)


def retention_group(zc, zx, gain, rope):
    log_decay = jnp.log1p(-jnp.exp2(-5.0 - jnp.arange(B_HEADS, dtype=jnp.float32)))

    def prep(z, use_rope):
        zq, zk, zv, zg = z
        q = to_heads(zq, B_HEADS)
        k = to_heads(zk, B_HEADS) * (B_DK ** -0.5)
        if use_rope:
            q, k = apply_rope(q, *rope), apply_rope(k, *rope)
        lf = jnp.broadcast_to(log_decay[:, None, None], q.shape)
        return q, to_heads(zv, B_HEADS), [(k, lf), (k, lf)], zg

    q_c, v_c, kf_c, g_c = prep(zc, False)
    q_x, v_x, kf_x, g_x = prep(zx, True)
    o_c, o_x = bidirectional_gla(q_c, v_c, kf_c, q_x, v_x, kf_x)
    out = lambda o, g: from_heads(rms_norm(o, gain)) * jax.nn.silu(g)
    return out(o_c, g_c), out(o_x, g_x)


def diff_attend(q1, q2, k1, k2, v, lam):
    scale = C_DQK ** -0.5
    s1 = jnp.einsum('bhqd,bhkd->bhqk', q1, k1).astype(jnp.float32) * scale
    s2 = jnp.einsum('bhqd,bhkd->bhqk', q2, k2).astype(jnp.float32) * scale
    a = jax.nn.softmax(s1, axis=-1) - lam * jax.nn.softmax(s2, axis=-1)
    return jnp.einsum('bhqk,bhkv->bhqv', a.astype(v.dtype), v)


def blocked_diff_attention(q1, q2, k1, k2, v, lam):
    b_, h, n_tok, d = q1.shape
    n = n_tok // Q_BLOCK
    qb = lambda t: jnp.moveaxis(t.reshape(b_, h, n, Q_BLOCK, d), 2, 0)
    out = lax.map(lambda xs: diff_attend(xs[0], xs[1], k1, k2, v, lam), (qb(q1), qb(q2)))
    return jnp.moveaxis(out, 0, 2).reshape(b_, h, n_tok, -1)


def diff_attn_group(zc, zx, lam_vecs, gain, rope, layer_idx, ctx_out):
    lam_init = 0.8 - 0.6 * math.exp(-0.3 * layer_idx)
    lv = lam_vecs.astype(jnp.float32)
    lam = jnp.exp(jnp.sum(lv[0] * lv[1])) - jnp.exp(jnp.sum(lv[2] * lv[3])) + lam_init

    def prep(z):
        zq, zk, zv = z
        q1, q2 = jnp.split(to_heads(zq, C_HEADS), 2, axis=-1)
        k1, k2 = jnp.split(to_heads(zk, C_HEADS), 2, axis=-1)
        return q1, q2, k1, k2, to_heads(zv, C_HEADS)

    q1c, q2c, k1c, k2c, vc = prep(zc)
    q1x, q2x, k1x, k2x, vx = prep(zx)
    q1x, q2x, k1x, k2x = (apply_rope(t, *rope) for t in (q1x, q2x, k1x, k2x))
    k1 = jnp.concatenate([k1c, k1x], axis=2)
    k2 = jnp.concatenate([k2c, k2x], axis=2)
    v = jnp.concatenate([vc, vx], axis=2)
    out = lambda o: from_heads(rms_norm(o, gain) * (1.0 - lam_init))
    o_x = out(blocked_diff_attention(q1x, q2x, k1, k2, v, lam))
    o_c = out(diff_attend(q1c, q2c, k1c, k2c, vc, lam)) if ctx_out else None
    return o_c, o_x


def depthwise_conv(t, w, b):
    out = lax.conv_general_dilated(t, w[:, None, :].astype(t.dtype), window_strides=(1,),
                                   padding=((D_CONV_LEFT, D_CONV - 1 - D_CONV_LEFT),),
                                   dimension_numbers=('NWC', 'WIO', 'NWC'),
                                   feature_group_count=t.shape[-1])
    return out + b


def block_diag_linear(t, w, b):
    b_, n, ch = t.shape
    y = jnp.einsum('btgi,gio->btgo', t.reshape(b_, n, w.shape[0], -1), w.astype(t.dtype))
    return y.reshape(b_, n, ch) + b


def rglru_coeffs(t, w_r, b_r, w_i, b_i, lam):
    t = t.astype(jnp.float32)
    r = jax.nn.sigmoid(block_diag_linear(t, w_r, b_r))
    i = jax.nn.sigmoid(block_diag_linear(t, w_i, b_i))
    log_a = -RG_C * r * jax.nn.softplus(-lam.astype(jnp.float32))
    return jnp.exp(log_a), jnp.sqrt(-jnp.expm1(2.0 * log_a)) * (i * t)


def linear_scan(a, u, h0):
    u = u.at[:, 0].add(a[:, 0] * h0)
    combine = lambda l, r: (r[0] * l[0], r[0] * l[1] + r[1])
    _, h = lax.associative_scan(combine, (a, u), axis=1)
    return h


def rglru_group(zc, zx, p):
    (xc, gc), (xx, gx) = zc, zx
    xc = depthwise_conv(xc, p['d_conv_w'], p['d_conv_b'])
    xx = depthwise_conv(xx, p['d_conv_w'], p['d_conv_b'])
    h_c_sum, h_x_sum = 0.0, 0.0
    for d in range(2):
        rev = d == 1
        coeffs = lambda t: rglru_coeffs(maybe_flip(t, 1, rev), p['d_w_r'][d], p['d_b_r'][d],
                                        p['d_w_i'][d], p['d_b_i'][d], p['d_lambda'][d])
        a_c, u_c = coeffs(xc)
        h_c = linear_scan(a_c, u_c, jnp.zeros((xc.shape[0], D_WIDTH), jnp.float32))
        a_x, u_x = coeffs(xx)
        h_x = linear_scan(a_x, u_x, h_c[:, -1])
        h_c_sum = h_c_sum + maybe_flip(h_c, 1, rev)
        h_x_sum = h_x_sum + maybe_flip(h_x, 1, rev)
    return (jax.nn.gelu(gc) * h_c_sum.astype(gc.dtype), jax.nn.gelu(gx) * h_x_sum.astype(gx.dtype))


def token_mixer(uc, ux, p, rope, layer_idx, ctx_out):
    zc = split_cols(uc @ p['w_in'])
    zx = split_cols(ux @ p['w_in'])
    a_c, a_x = hgrn2_group(zc[0:5], zx[0:5], p['lower_bound'], p['a_norm'])
    b_c, b_x = retention_group(zc[5:9], zx[5:9], p['b_norm'], rope)
    c_c, c_x = diff_attn_group(zc[9:12], zx[9:12], p['c_lambda'], p['c_norm'], rope, layer_idx, ctx_out)
    d_c, d_x = rglru_group(zc[12:14], zx[12:14], p)
    y_x = jnp.concatenate([a_x, b_x, c_x, d_x], axis=-1) @ p['w_out']
    y_c = jnp.concatenate([a_c, b_c, c_c, d_c], axis=-1) @ p['w_out'] if ctx_out else None
    return y_c, y_x


def ffn_sublayer(h, mod, p, ffn_idx, norm_idx):
    shift, scale, gate = mod
    u = modulate(rms_norm(h, p['norm_pre'][norm_idx]), shift, scale)
    g, up = jnp.split(u @ p['ffn_w_in'][ffn_idx], 2, axis=-1)
    y = (jax.nn.silu(g) * up) @ p['ffn_w_out'][ffn_idx]
    return h + FFN_RESIDUAL * gate * rms_norm(y, p['norm_post'][norm_idx])


def hybrid_layer(hc, hx, c_silu, cc_silu, p, rope, layer_idx, ctx_out):
    mod_x = jnp.split((c_silu @ p['w_ada'] + p['b_ada'])[:, None, :], N_MOD, axis=-1)
    mod_c = jnp.split((cc_silu @ p['w_ada'] + p['b_ada'])[None, None, :], N_MOD, axis=-1)
    hc = ffn_sublayer(hc, mod_c[0:3], p, 0, 0)
    hx = ffn_sublayer(hx, mod_x[0:3], p, 0, 0)
    uc = modulate(rms_norm(hc, p['norm_pre'][1]), mod_c[3], mod_c[4])
    ux = modulate(rms_norm(hx, p['norm_pre'][1]), mod_x[3], mod_x[4])
    y_c, y_x = token_mixer(uc, ux, p, rope, layer_idx, ctx_out)
    hx = hx + mod_x[5] * rms_norm(y_x, p['norm_post'][1])
    hx = ffn_sublayer(hx, mod_x[6:9], p, 1, 2)
    if ctx_out:
        hc = hc + mod_c[5] * rms_norm(y_c, p['norm_post'][1])
        hc = ffn_sublayer(hc, mod_c[6:9], p, 1, 2)
    else:
        hc = None
    return hc, hx


def setup_inputs(seed: int = 0) -> dict:
    key = jax.random.key(seed)
    ks = jax.random.split(key, 24)
    f32 = jnp.float32
    nrm = lambda k, shape, scale: jax.random.normal(k, shape, f32) * scale
    gain = lambda k, shape: 1.0 + 0.05 * jax.random.normal(k, shape, f32)
    bs = D_WIDTH // D_BLOCKS
    a0 = jax.random.uniform(ks[23], (DEPTH, 2, D_WIDTH), f32, 0.9, 0.999) ** (1.0 / RG_C)
    return {
        "x": nrm(ks[0], (BATCH, SEQ, D_MODEL), 1.0),
        "c": nrm(ks[1], (BATCH, D_MODEL), 1.0),
        "ctx": nrm(ks[2], (BATCH, CTX_LEN, D_MODEL), 1.0),
        "c_ctx": nrm(ks[3], (D_MODEL,), 1.0),
        "w_ada": nrm(ks[4], (DEPTH, D_MODEL, N_MOD * D_MODEL), 0.5 * D_MODEL ** -0.5),
        "b_ada": nrm(ks[5], (DEPTH, N_MOD * D_MODEL), 0.02),
        "norm_pre": gain(ks[6], (DEPTH, 3, D_MODEL)),
        "norm_post": gain(ks[7], (DEPTH, 3, D_MODEL)),
        "ffn_w_in": nrm(ks[8], (DEPTH, 2, D_MODEL, 2 * D_FF), D_MODEL ** -0.5),
        "ffn_w_out": nrm(ks[9], (DEPTH, 2, D_FF, D_MODEL), D_FF ** -0.5),
        "w_in": nrm(ks[10], (DEPTH, D_MODEL, IN_WIDTH), D_MODEL ** -0.5),
        "w_out": nrm(ks[11], (DEPTH, MIX_WIDTH, D_MODEL), MIX_WIDTH ** -0.5),
        "lb_logits": nrm(ks[12], (DEPTH, 2, A_HEADS * A_DK), 1.0),
        "a_norm": gain(ks[13], (DEPTH, A_DV)),
        "b_norm": gain(ks[14], (DEPTH, B_DV)),
        "c_lambda": nrm(ks[15], (DEPTH, 4, C_DQK), 0.1),
        "c_norm": gain(ks[16], (DEPTH, C_DV)),
        "d_conv_w": nrm(ks[17], (DEPTH, D_CONV, D_WIDTH), D_CONV ** -0.5),
        "d_conv_b": nrm(ks[18], (DEPTH, D_WIDTH), 0.02),
        "d_w_r": nrm(ks[19], (DEPTH, 2, D_BLOCKS, bs, bs), bs ** -0.5),
        "d_b_r": nrm(ks[20], (DEPTH, 2, D_WIDTH), 0.02),
        "d_w_i": nrm(ks[21], (DEPTH, 2, D_BLOCKS, bs, bs), bs ** -0.5),
        "d_b_i": nrm(ks[22], (DEPTH, 2, D_WIDTH), 0.02),
        "d_lambda": jnp.log(a0) - jnp.log1p(-a0),
    }


def reference(x, c, ctx, c_ctx, w_ada, b_ada, norm_pre, norm_post, ffn_w_in, ffn_w_out,
              w_in, w_out, lb_logits, a_norm, b_norm, c_lambda, c_norm, d_conv_w, d_conv_b,
              d_w_r, d_b_r, d_w_i, d_b_i, d_lambda):
    rows = x.shape[1] // GRID_W
    rope = axial_rope_tables(rows, HEAD_DIM)
    lower_bounds = lower_bounds_from_logits(lb_logits)
    c_silu = jax.nn.silu(c)
    cc_silu = jax.nn.silu(c_ctx)
    hc, hx = ctx, x
    for l in range(DEPTH):
        p = dict(w_ada=w_ada[l], b_ada=b_ada[l], norm_pre=norm_pre[l], norm_post=norm_post[l],
                 ffn_w_in=ffn_w_in[l], ffn_w_out=ffn_w_out[l], w_in=w_in[l], w_out=w_out[l],
                 lower_bound=lower_bounds[l], a_norm=a_norm[l], b_norm=b_norm[l],
                 c_lambda=c_lambda[l], c_norm=c_norm[l], d_conv_w=d_conv_w[l], d_conv_b=d_conv_b[l],
                 d_w_r=d_w_r[l], d_b_r=d_b_r[l], d_w_i=d_w_i[l], d_b_i=d_b_i[l], d_lambda=d_lambda[l])
        hc, hx = hybrid_layer(hc, hx, c_silu, cc_silu, p, rope, l, l < DEPTH - 1)
    return hx
```

```cpp
#include <hip/hip_runtime.h>
#include <hip/hip_bf16.h>
#include <hip/hip_cooperative_groups.h>
#include <cstdio>
namespace cg = cooperative_groups;

typedef unsigned short bfu;
using bf16x8 = __attribute__((ext_vector_type(8))) short;
using f32x4 = __attribute__((ext_vector_type(4))) float;
using f32x2 = __attribute__((ext_vector_type(2))) float;
using u32x4 = __attribute__((ext_vector_type(4))) unsigned;
using u32x2 = __attribute__((ext_vector_type(2))) unsigned;

constexpr int DM = 2048, TPB = 2304, NROW = 9216, DFF = 5504, INW = 7168, NMOD = 18432;
constexpr int NT = 256;
constexpr float EPS = 1e-6f;

constexpr size_t SZ_WFIN = (size_t)2 * 2 * 11008 * 2048 * 2;
constexpr size_t SZ_WFOUT = (size_t)2 * 2 * 2048 * 5504 * 2;
constexpr size_t SZ_WIN = (size_t)2 * 7168 * 2048 * 2;
constexpr size_t SZ_WOUT = (size_t)2 * 2048 * 2048 * 2;
constexpr int KS_MOD = 16;
constexpr size_t SZ_MODP = (size_t)2 * KS_MOD * 5 * NMOD * 4;
constexpr size_t SZ_MOD = (size_t)2 * 5 * NMOD * 4;
constexpr size_t SZ_ROPE = (size_t)2048 * 32 * 8;
constexpr size_t SZ_H = (size_t)NROW * DM * 4;
constexpr size_t SZ_U = (size_t)NROW * DM * 2;
constexpr size_t SZ_Z = (size_t)NROW * INW * 4;
constexpr size_t SZ_ACT = (size_t)NROW * DFF * 2;
constexpr size_t SZ_QC = (size_t)NROW * 512 * 2;
constexpr size_t SZ_GU = (size_t)2 * 4 * 8 * 2 * 36 * 4096 * 4;
constexpr size_t SZ_GG = (size_t)2 * 4 * 8 * 2 * 36 * 64 * 4;
constexpr size_t SZ_OFWD = (size_t)2 * NROW * 1024 * 4;
constexpr size_t SZ_AU = (size_t)2 * NROW * 512 * 8;
constexpr size_t SZ_PH = (size_t)4 * 2 * 144 * 512 * 8;

constexpr size_t OFF_WFIN = 0;
constexpr size_t OFF_WFOUT = OFF_WFIN + SZ_WFIN;
constexpr size_t OFF_WIN = OFF_WFOUT + SZ_WFOUT;
constexpr size_t OFF_WOUT = OFF_WIN + SZ_WIN;
constexpr size_t OFF_MODP = OFF_WOUT + SZ_WOUT;
constexpr size_t OFF_MOD = OFF_MODP + SZ_MODP;
constexpr size_t OFF_ROPE = OFF_MOD + SZ_MOD;
constexpr size_t OFF_H = OFF_ROPE + SZ_ROPE;
constexpr size_t OFF_U = OFF_H + SZ_H;
constexpr size_t OFF_Z = OFF_U + SZ_U;
constexpr size_t OFF_ACT = OFF_Z;
constexpr size_t OFF_Y = OFF_Z + SZ_ACT;
constexpr size_t OFF_QC = OFF_Z + SZ_Z;
constexpr size_t OFF_KC = OFF_QC + SZ_QC;
constexpr size_t OFF_VT = OFF_KC + SZ_QC;
constexpr size_t OFF_MIX = OFF_VT + SZ_QC;
constexpr size_t OFF_GU = OFF_MIX + SZ_U;
constexpr size_t OFF_GG = OFF_GU + SZ_GU;
constexpr size_t OFF_OFWD = OFF_GG + SZ_GG;
constexpr size_t OFF_AU = OFF_OFWD + SZ_OFWD;
constexpr size_t OFF_PH = OFF_AU + SZ_AU;
constexpr size_t OFF_BAR = OFF_PH + SZ_PH;
constexpr size_t OFF_ZB = OFF_BAR + 16384;
constexpr size_t WS_NEED = OFF_ZB + (size_t)NROW * INW * 2;

struct Params {
  const float *x, *c, *ctx, *c_ctx, *w_ada, *b_ada, *norm_pre, *norm_post, *ffn_w_in, *ffn_w_out, *w_in, *w_out,
      *lb_logits, *a_norm, *b_norm, *c_lambda, *c_norm, *d_conv_w, *d_conv_b, *d_w_r, *d_b_r, *d_w_i, *d_b_i, *d_lambda;
  float* out;
  char* ws;
};

__device__ __forceinline__ bfu f2bf(float f) {
  unsigned u = __float_as_uint(f);
  u += 0x7fffu + ((u >> 16) & 1u);
  return (bfu)(u >> 16);
}
typedef __bf16 bf16v2_t __attribute__((ext_vector_type(2)));
__device__ __forceinline__ unsigned pack2(float a, float b) {
  bf16v2_t r = __builtin_convertvector((f32x2){a, b}, bf16v2_t);
  return __builtin_bit_cast(unsigned, r);
}
__device__ __forceinline__ float ldb(const bfu* p) { return __uint_as_float((unsigned)(*p) << 16); }
__device__ __forceinline__ float sigmoidf_(float x) { return __builtin_amdgcn_rcpf(1.f + __builtin_amdgcn_exp2f(-1.44269504088896f * x)); }
__device__ __forceinline__ float siluf_(float x) { return x * sigmoidf_(x); }
__device__ __forceinline__ float geluf_(float x) {
  float y = 0.7978845608028654f * (x + 0.044715f * x * x * x);
  float t = 1.f - 2.f / (1.f + __expf(2.f * y));
  return 0.5f * x * (1.f + t);
}
__device__ __forceinline__ float wave_sum(float v) {
#pragma unroll
  for (int o = 32; o >= 1; o >>= 1) v += __shfl_xor(v, o);
  return v;
}
__device__ __forceinline__ void wave_fence() {
  __builtin_amdgcn_fence(__ATOMIC_RELEASE, "wavefront");
  __builtin_amdgcn_wave_barrier();
  __builtin_amdgcn_fence(__ATOMIC_ACQUIRE, "wavefront");
}

struct Ctx {
  int tid;
  int vb, vg;
  char* lds;
};

#define LAS __attribute__((address_space(3)))
constexpr int BM = 256, BK = 64, HALF = 128, HTB = HALF * BK * 2, NXCD = 8, WGM = 8;
__device__ __forceinline__ int lds_byte(int r, int c) {
  const int st = (r >> 4) * 2 + (c >> 5), rr = r & 15, cc = c & 31, ob = rr * 64 + cc * 2;
  return st * 1024 + (ob ^ (((ob >> 9) & 1) << 5));
}
__device__ __forceinline__ void stage_rc(int b, int& R, int& C) {
  const int st = b / 1024, sb = b % 1024, swz = sb ^ (((sb >> 9) & 1) << 5);
  R = (st >> 1) * 16 + swz / 64;
  C = (st & 1) * 32 + (swz % 64) / 2;
}
struct Unit { int pm, pn, ks; };
struct Gemm {
  const bfu* A; const bfu* Bt;
  int M, N, lda;
  int S;
  int latent_only;
  int nt0, nt1;
};
struct StaticOrder {
  int nM, nN, per, nwg, G, c, lat;
  __device__ void init(const Gemm& g, int G_, int c_) { lat = g.latent_only; nM = g.M / BM; nN = g.N / BM; per = nM * nN; nwg = per * g.S; G = G_; c = c_; }
  __device__ bool next(int i, Unit& u) const {
    const long L = (long)i * G + c;
    if (L >= nwg) return false;
    int wgid = (int)L;
    { const int q = nwg / NXCD, r = nwg % NXCD, xcd = wgid % NXCD, off = wgid / NXCD; wgid = (xcd < r ? xcd * (q + 1) : r * (q + 1) + (xcd - r) * q) + off; }
    u.ks = wgid / per; wgid = wgid % per;
    const int nig = WGM * nN, gid = wgid / nig, fm = gid * WGM, gsz = (nM - fm) < WGM ? (nM - fm) : WGM;
    u.pm = fm + ((wgid % nig) % gsz); u.pn = (wgid % nig) / gsz;
    if (lat) u.pm = (u.pm >> 3) * 9 + 1 + (u.pm & 7);
    return true;
  }
};

struct EpiF32 {
  bfu* C; int ldc; size_t part_stride;
  __device__ __forceinline__ void operator()(const f32x4 (&acc)[2][2][4][2], const Unit& u, int wr, int wc, int fr, int fq) const {
    const int row0 = u.pm * BM + wr * 64 + fr, col0 = u.pn * BM + wc * 32 + 4 * fq;
    bfu* Cb = C + (size_t)u.ks * part_stride;
#pragma unroll
    for (int ai = 0; ai < 2; ++ai)
#pragma unroll
      for (int m = 0; m < 4; ++m) {
        bfu* rowp = Cb + (size_t)(row0 + ai * HALF + m * 16) * ldc + col0;
#pragma unroll
        for (int bj = 0; bj < 2; ++bj)
#pragma unroll
          for (int n = 0; n < 2; ++n) {
            const f32x4 v = acc[ai][bj][m][n];
            uint2 o; o.x = pack2(v[0], v[1]); o.y = pack2(v[2], v[3]);
            *reinterpret_cast<uint2*>(rowp + bj * HALF + n * 16) = o;
          }
      }
  }
};
struct EpiSwiglu {
  bfu* act;
  __device__ __forceinline__ void operator()(const f32x4 (&acc)[2][2][4][2], const Unit& u, int wr, int wc, int fr, int fq) const {
    const int row0 = u.pm * BM + wr * 64 + fr;
#pragma unroll
    for (int ai = 0; ai < 2; ++ai)
#pragma unroll
      for (int m = 0; m < 4; ++m) {
        bfu* rowp = act + (size_t)(row0 + ai * HALF + m * 16) * DFF;
#pragma unroll
        for (int bj = 0; bj < 2; ++bj) {
          const int oc = (u.pn * BM + bj * HALF + wc * 32) / 2 + 4 * fq;
          const f32x4 g = acc[ai][bj][m][0], up = acc[ai][bj][m][1];
          uint2 o;
          o.x = pack2(siluf_(g[0]) * up[0], siluf_(g[1]) * up[1]);
          o.y = pack2(siluf_(g[2]) * up[2], siluf_(g[3]) * up[3]);
          *reinterpret_cast<uint2*>(rowp + oc) = o;
        }
      }
  }
};
struct EpiZin {
  float* z; bfu *qc, *kc, *vt; const float* rope;
  bfu* zb;
  const float* lb_logits; int layer;
  __device__ __forceinline__ void operator()(const f32x4 (&acc)[2][2][4][2], const Unit& u, int wr, int wc, int fr, int fq) const {
    const int brow = u.pm * BM;
    const int bb = brow / TPB, tbase = brow % TPB;
    const bool latent = tbase >= 256;
#pragma unroll
    for (int bj = 0; bj < 2; ++bj) {
      const int cb = u.pn * BM + bj * HALF + wc * 32;
      const int sec = cb >> 9;
      const bool ropesec = (sec == 5 || sec == 6 || sec == 9 || sec == 10);
      const float sc = (sec == 6) ? 0.125f : (sec == 9 ? 0.125f * 1.44269504088896f : 1.f);
      const int c0 = ropesec ? ((cb & ~63) + 16 * ((cb >> 5) & 1) + 4 * fq) : (cb + 4 * fq);
      const int cstep = ropesec ? 32 : 16;
      float lb0[4] = {0.f, 0.f, 0.f, 0.f}, lb1[4] = {0.f, 0.f, 0.f, 0.f};
      if ((sec == 1 || sec == 2) && layer == 1) {
#pragma unroll
        for (int j = 0; j < 4; ++j) {
          const int ca = (c0 & 511) + j, cb2 = ca + 16;
          const float* lg = lb_logits + (sec - 1) * 512;
          float a0 = lg[ca], a1 = lg[1024 + ca], mx = fmaxf(a0, a1);
          float e0 = __expf(a0 - mx), e1 = __expf(a1 - mx);
          lb0[j] = e1 / (e0 + e1);
          a0 = lg[cb2]; a1 = lg[1024 + cb2]; mx = fmaxf(a0, a1);
          e0 = __expf(a0 - mx); e1 = __expf(a1 - mx);
          lb1[j] = e1 / (e0 + e1);
        }
      }
#pragma unroll
      for (int ai = 0; ai < 2; ++ai)
#pragma unroll
        for (int m = 0; m < 4; ++m) {
          const int rl = ai * HALF + wr * 64 + m * 16 + fr;
          const int row = brow + rl;
          f32x4 v0 = acc[ai][bj][m][0] * sc, v1 = acc[ai][bj][m][1] * sc;
          if (sec == 0 || sec == 4 || sec == 8) {
#pragma unroll
            for (int j = 0; j < 4; ++j) { v0[j] = siluf_(v0[j]); v1[j] = siluf_(v1[j]); }
          } else if (sec == 13) {
#pragma unroll
            for (int j = 0; j < 4; ++j) { v0[j] = geluf_(v0[j]); v1[j] = geluf_(v1[j]); }
          } else if (sec == 1 || sec == 2) {
#pragma unroll
            for (int j = 0; j < 4; ++j) {
              v0[j] = lb0[j] + (1.f - lb0[j]) * sigmoidf_(v0[j]);
              v1[j] = lb1[j] + (1.f - lb1[j]) * sigmoidf_(v1[j]);
            }
          }
          if (ropesec && latent) {
            const int tl = tbase - 256 + rl;
            const float* rp = rope + ((size_t)tl * 32 + (c0 & 31)) * 2;
            const f32x4 r0 = *reinterpret_cast<const f32x4*>(rp), r1 = *reinterpret_cast<const f32x4*>(rp + 4);
            const float cs[4] = {r0[0], r0[2], r1[0], r1[2]}, sn[4] = {r0[1], r0[3], r1[1], r1[3]};
#pragma unroll
            for (int j = 0; j < 4; ++j) {
              const float x1 = v0[j], x2 = v1[j];
              v0[j] = x1 * cs[j] - x2 * sn[j];
              v1[j] = x2 * cs[j] + x1 * sn[j];
            }
          }
          if (sec == 9 || sec == 10) {
            bfu* dst = (sec == 9 ? qc : kc) + (size_t)row * 512 + (c0 - (sec == 9 ? 4608 : 5120));
            uint2 o0, o1;
            o0.x = pack2(v0[0], v0[1]); o0.y = pack2(v0[2], v0[3]);
            o1.x = pack2(v1[0], v1[1]); o1.y = pack2(v1[2], v1[3]);
            *reinterpret_cast<uint2*>(dst) = o0;
            *reinterpret_cast<uint2*>(dst + cstep) = o1;
          } else if (sec == 11) {
            const int t = tbase + rl;
            bfu* dst = vt + ((size_t)bb * 512 + (c0 - 5632)) * TPB + t;
#pragma unroll
            for (int j = 0; j < 4; ++j) {
              dst[(size_t)j * TPB] = f2bf(v0[j]);
              dst[(size_t)(16 + j) * TPB] = f2bf(v1[j]);
            }
          } else {
            if (sec == 1 || sec == 2) {
              float* dst = z + (size_t)row * INW + c0;
              *reinterpret_cast<f32x4*>(dst) = v0;
              *reinterpret_cast<f32x4*>(dst + cstep) = v1;
            } else {
              bfu* dst = zb + (size_t)row * INW + c0;
              *reinterpret_cast<u32x2*>(dst) = (u32x2){pack2(v0[0], v0[1]), pack2(v0[2], v0[3])};
              *reinterpret_cast<u32x2*>(dst + cstep) = (u32x2){pack2(v1[0], v1[1]), pack2(v1[2], v1[3])};
            }
          }
        }
    }
  }
};

template <class Epi>
__device__ __forceinline__ void gemm_phase(const int tid, LAS unsigned char* lds, const Gemm g, const StaticOrder& S, const Epi& E) {
  const int wid = __builtin_amdgcn_readfirstlane(tid >> 6), lane = tid & 63, wr = wid >> 2, wc = wid & 3, fr = lane & 15, fq = lane >> 4;
  const int lda = g.lda;
  unsigned voffA[2];
#pragma unroll
  for (int i = 0; i < 2; ++i) { int R, C; stage_rc(tid * 16 + i * 8192, R, C); voffA[i] = (unsigned)(R * lda + C) * 2u; }
  const size_t kstep = (size_t)(BK * 2);
  const size_t hstep = (size_t)HALF * lda * 2;
  const size_t tstep = 2 * hstep;
  const unsigned ldsw = (unsigned)wid * 1024u;
  const int aoff = lds_byte(wr * 64 + fr, fq * 8), boff = lds_byte(wc * 32 + fr, fq * 8);
#define PG8_SA(b, h) (((b) * 2 + (h)) * HTB)
#define PG8_SB(b, h) ((4 + (b) * 2 + (h)) * HTB)
#define PG8_STAGE(bufoff, gbase, voff) do { _Pragma("unroll") for (int _i = 0; _i < 2; ++_i) \
        __builtin_amdgcn_global_load_lds((const unsigned*)((const char*)(gbase) + (voff)[_i]), (LAS unsigned*)(lds + (bufoff) + ldsw + _i * 8192), 16, 0, 0); } while (0)
#define PG8_LDA(dst, b, h) do { _Pragma("unroll") for (int m = 0; m < 4; ++m) _Pragma("unroll") for (int k = 0; k < 2; ++k) dst[m][k] = *(const LAS bf16x8*)(lds + PG8_SA(b, h) + aoff + m * 2048 + k * 1024); } while (0)
#define PG8_LDB(dst, b, h) do { _Pragma("unroll") for (int n = 0; n < 2; ++n) _Pragma("unroll") for (int k = 0; k < 2; ++k) dst[n][k] = *(const LAS bf16x8*)(lds + PG8_SB(b, h) + boff + n * 2048 + k * 1024); } while (0)
#define PG8_MMA(ai, bj, At, Bt) do { __builtin_amdgcn_s_setprio(1); _Pragma("unroll") for (int m = 0; m < 4; ++m) _Pragma("unroll") for (int n = 0; n < 2; ++n) _Pragma("unroll") for (int k = 0; k < 2; ++k) \
        acc[ai][bj][m][n] = __builtin_amdgcn_mfma_f32_16x16x32_bf16(Bt[n][k], At[m][k], acc[ai][bj][m][n], 0, 0, 0); __builtin_amdgcn_s_setprio(0); } while (0)
#define PG8_WAIT_V(n) asm volatile("s_waitcnt vmcnt(" #n ")" ::: "memory")
#define PG8_WAIT_L(n) asm volatile("s_waitcnt lgkmcnt(" #n ")" ::: "memory")
#define PG8_BAR __builtin_amdgcn_s_barrier()
#define PG8_SCHED __builtin_amdgcn_sched_barrier(0)
  Unit cur, nxt; int ui = 0;
  if (!S.next(0, cur)) return;
  f32x4 acc[2][2][4][2];
#pragma unroll
  for (int a = 0; a < 2; ++a)
#pragma unroll
    for (int b = 0; b < 2; ++b)
#pragma unroll
      for (int m = 0; m < 4; ++m)
#pragma unroll
        for (int n = 0; n < 2; ++n) acc[a][b][m][n] = (f32x4){0.f, 0.f, 0.f, 0.f};
  bf16x8 At[4][2], B0[2][2], B1[2][2];
  const size_t ks1 = (size_t)g.nt0 * kstep;
  const char* cA = (const char*)g.A + (size_t)cur.pm * tstep + (cur.ks ? ks1 : 0);
  const char* cB = (const char*)g.Bt + (size_t)cur.pn * tstep + (cur.ks ? ks1 : 0);
  int nt = cur.ks ? g.nt1 : g.nt0;
  PG8_STAGE(PG8_SB(0, 0), cB, voffA); PG8_STAGE(PG8_SA(0, 0), cA, voffA); PG8_STAGE(PG8_SB(0, 1), cB + hstep, voffA); PG8_STAGE(PG8_SA(0, 1), cA + hstep, voffA);
  if (wr == 1) PG8_BAR;
  PG8_WAIT_V(4); PG8_BAR;
  PG8_STAGE(PG8_SB(1, 0), cB + kstep, voffA); PG8_STAGE(PG8_SA(1, 0), cA + kstep, voffA); PG8_STAGE(PG8_SB(1, 1), cB + hstep + kstep, voffA);
  PG8_WAIT_V(6); PG8_BAR;
  for (;;) {
    const bool has_next = S.next(ui + 1, nxt);
    const char* nA = has_next ? (const char*)g.A + (size_t)nxt.pm * tstep + (nxt.ks ? ks1 : 0) : cA;
    const char* nB = has_next ? (const char*)g.Bt + (size_t)nxt.pn * tstep + (nxt.ks ? ks1 : 0) : cB;
#pragma unroll 1
    for (int t = 0; t < nt; t += 2) {
      const bool last = (t == nt - 2);
      const char* a1 = cA + (size_t)(t + 1) * kstep;
      const char* a2 = last ? nA : cA + (size_t)(t + 2) * kstep; const char* b2 = last ? nB : cB + (size_t)(t + 2) * kstep;
      const char* a3 = a2 + kstep; const char* b3 = b2 + kstep;
      PG8_LDB(B0, 0, 0); PG8_SCHED; PG8_LDA(At, 0, 0); PG8_STAGE(PG8_SA(1, 1), a1 + hstep, voffA);
      PG8_WAIT_L(8); PG8_BAR; PG8_WAIT_L(0); PG8_MMA(0, 0, At, B0); PG8_BAR; PG8_SCHED;
      PG8_LDB(B1, 0, 1); PG8_STAGE(PG8_SB(0, 0), b2, voffA);
      PG8_BAR; PG8_WAIT_L(0); PG8_MMA(0, 1, At, B1); PG8_BAR;
      PG8_LDA(At, 0, 1); PG8_STAGE(PG8_SA(0, 0), a2, voffA);
      PG8_BAR; PG8_WAIT_L(0); PG8_MMA(1, 0, At, B0); PG8_BAR; PG8_SCHED;
      PG8_STAGE(PG8_SB(0, 1), b2 + hstep, voffA);
      PG8_WAIT_V(6); PG8_BAR; PG8_MMA(1, 1, At, B1); PG8_BAR;
      PG8_LDB(B0, 1, 0); PG8_SCHED; PG8_LDA(At, 1, 0); PG8_STAGE(PG8_SA(0, 1), a2 + hstep, voffA);
      PG8_WAIT_L(8); PG8_BAR; PG8_WAIT_L(0); PG8_MMA(0, 0, At, B0); PG8_BAR; PG8_SCHED;
      PG8_LDB(B1, 1, 1); PG8_STAGE(PG8_SB(1, 0), b3, voffA);
      PG8_BAR; PG8_WAIT_L(0); PG8_MMA(0, 1, At, B1); PG8_BAR;
      PG8_LDA(At, 1, 1); PG8_STAGE(PG8_SA(1, 0), a3, voffA);
      PG8_BAR; PG8_WAIT_L(0); PG8_MMA(1, 0, At, B0); PG8_BAR; PG8_SCHED;
      PG8_STAGE(PG8_SB(1, 1), b3 + hstep, voffA);
      PG8_WAIT_V(6); PG8_BAR; PG8_MMA(1, 1, At, B1); PG8_BAR;
    }
    E(acc, cur, wr, wc, fr, fq);
    if (!has_next) break;
#pragma unroll
    for (int a = 0; a < 2; ++a)
#pragma unroll
      for (int b = 0; b < 2; ++b)
#pragma unroll
        for (int m = 0; m < 4; ++m)
#pragma unroll
          for (int n = 0; n < 2; ++n) acc[a][b][m][n] = (f32x4){0.f, 0.f, 0.f, 0.f};
    cur = nxt; cA = nA; cB = nB; ++ui;
    nt = cur.ks ? g.nt1 : g.nt0;
  }
  PG8_WAIT_V(0);
  if (wr == 0) PG8_BAR;
  PG8_BAR;
#undef PG8_SA
#undef PG8_SB
#undef PG8_STAGE
#undef PG8_LDA
#undef PG8_LDB
#undef PG8_MMA
#undef PG8_WAIT_V
#undef PG8_WAIT_L
#undef PG8_BAR
#undef PG8_SCHED
}

__device__ __forceinline__ void conv_tile(const Ctx& cx, const float* __restrict__ src, bfu* __restrict__ dst, int K, int N, int kt, int nt, int perm) {
  char* smem = cx.lds;
  float* tile = reinterpret_cast<float*>(smem);
  const int tid = cx.tid;
  const int k0 = kt * 64, n0 = nt * 64;
#pragma unroll
  for (int i = 0; i < 4; ++i) {
    int kk = (tid >> 4) + 16 * i, nn = (tid & 15) * 4;
    float4 v = *reinterpret_cast<const float4*>(src + (size_t)(k0 + kk) * N + n0 + nn);
    tile[kk * 65 + nn] = v.x; tile[kk * 65 + nn + 1] = v.y; tile[kk * 65 + nn + 2] = v.z; tile[kk * 65 + nn + 3] = v.w;
  }
  __syncthreads();
#pragma unroll
  for (int i = 0; i < 2; ++i) {
    int q = tid + 256 * i, nn = q >> 3, kc = q & 7;
    int j = n0 + nn, drow = j;
    if (perm == 1) {
      if (j < DFF) drow = (j >> 4) * 32 + (j & 15);
      else { int jj = j - DFF; drow = (jj >> 4) * 32 + 16 + (jj & 15); }
    } else if (perm == 2) {
      int sec = j >> 9;
      if (sec == 5 || sec == 6 || sec == 9 || sec == 10) {
        int d = j & 63;
        int pos = d < 16 ? d : (d < 32 ? d + 16 : (d < 48 ? d - 16 : d));
        drow = (j & ~63) + pos;
      }
    }
    uint4 o;
    o.x = pack2(tile[(kc * 8 + 0) * 65 + nn], tile[(kc * 8 + 1) * 65 + nn]);
    o.y = pack2(tile[(kc * 8 + 2) * 65 + nn], tile[(kc * 8 + 3) * 65 + nn]);
    o.z = pack2(tile[(kc * 8 + 4) * 65 + nn], tile[(kc * 8 + 5) * 65 + nn]);
    o.w = pack2(tile[(kc * 8 + 6) * 65 + nn], tile[(kc * 8 + 7) * 65 + nn]);
    *reinterpret_cast<uint4*>(dst + (size_t)drow * K + k0 + kc * 8) = o;
  }
  __syncthreads();
}

__device__ __forceinline__ void conv_item(const Ctx& cx, const Params& p, int l, int r) {
  if (r < 11008) {
    int f = r / 5504, rr = r % 5504;
    conv_tile(cx, p.ffn_w_in + (size_t)(l * 2 + f) * 2048 * 11008, reinterpret_cast<bfu*>(p.ws + OFF_WFIN) + (size_t)(l * 2 + f) * 11008 * 2048,
              2048, 11008, rr / 172, rr % 172, 1);
  } else if (r < 16512) {
    r -= 11008;
    int f = r / 2752, rr = r % 2752;
    conv_tile(cx, p.ffn_w_out + (size_t)(l * 2 + f) * 5504 * 2048, reinterpret_cast<bfu*>(p.ws + OFF_WFOUT) + (size_t)(l * 2 + f) * 2048 * 5504,
              5504, 2048, rr / 32, rr % 32, 0);
  } else if (r < 20096) {
    r -= 16512;
    conv_tile(cx, p.w_in + (size_t)l * 2048 * 7168, reinterpret_cast<bfu*>(p.ws + OFF_WIN) + (size_t)l * 7168 * 2048, 2048, 7168, r / 112, r % 112, 2);
  } else {
    r -= 20096;
    conv_tile(cx, p.w_out + (size_t)l * 2048 * 2048, reinterpret_cast<bfu*>(p.ws + OFF_WOUT) + (size_t)l * 2048 * 2048, 2048, 2048, r / 32, r % 32, 0);
  }
}

__device__ __forceinline__ void conv_deferred(const Ctx& cx, const Params& p, int j) {
  int l, r;
  if (j < 2752) { l = 0; r = 11008 + j; }
  else if (j < 6336) { l = 0; r = 16512 + (j - 2752); }
  else if (j < 7360) { l = 0; r = 20096 + (j - 6336); }
  else if (j < 12864) { l = 0; r = 5504 + (j - 7360); }
  else if (j < 15616) { l = 0; r = 13760 + (j - 12864); }
  else if (j < 21120) { l = 1; r = (j - 15616); }
  else if (j < 23872) { l = 1; r = 11008 + (j - 21120); }
  else if (j < 27456) { l = 1; r = 16512 + (j - 23872); }
  else if (j < 28480) { l = 1; r = 20096 + (j - 27456); }
  else if (j < 33984) { l = 1; r = 5504 + (j - 28480); }
  else { l = 1; r = 13760 + (j - 33984); }
  conv_item(cx, p, l, r);
}

__device__ __forceinline__ void phase0(const Ctx& cx, const Params& p) {
  char* smem = cx.lds;
  const int tid = cx.tid;
  constexpr int N_MODP = 2 * 18 * KS_MOD;
  constexpr int N_ROPE = 256;
  constexpr int N_CONV = 5504;
  unsigned* p0ctr = reinterpret_cast<unsigned*>(p.ws + OFF_BAR) + 3520 + 6 * 64;
  volatile LAS unsigned* p0bc = (volatile LAS unsigned*)((LAS unsigned char*)(smem - (cx.vb & 1) * 65536) + 131072 + 8);
  for (;;) {
    __syncthreads();
    if ((cx.vb & 1) == 0 && tid == 0) p0bc[0] = __hip_atomic_fetch_add(p0ctr, 2u, __ATOMIC_RELAXED, __HIP_MEMORY_SCOPE_AGENT);
    __syncthreads();
    const int it = (int)p0bc[0] + (cx.vb & 1);
    if (it >= N_MODP + N_ROPE + N_CONV) break;
    if (it < N_MODP) {
      int ks = it % KS_MOD, t = it / KS_MOD, cb = t % 18, l = t / 18;
      float* cs = reinterpret_cast<float*>(smem);
      constexpr int KC = DM / KS_MOD;
      for (int i = tid; i < 5 * KC; i += NT) {
        int v = i / KC, k = i % KC;
        float cv = (v < 4) ? p.c[v * DM + ks * KC + k] : p.c_ctx[ks * KC + k];
        cs[i] = siluf_(cv);
      }
      __syncthreads();
      int col = cb * 1024 + tid * 4;
      float4 acc[5];
#pragma unroll
      for (int v = 0; v < 5; ++v) acc[v] = make_float4(0.f, 0.f, 0.f, 0.f);
      const float* wp = p.w_ada + ((size_t)l * DM + ks * KC) * NMOD + col;
#pragma unroll 4
      for (int k = 0; k < KC; ++k) {
        float4 w = *reinterpret_cast<const float4*>(wp + (size_t)k * NMOD);
#pragma unroll
        for (int v = 0; v < 5; ++v) {
          float s = cs[v * KC + k];
          acc[v].x += s * w.x; acc[v].y += s * w.y; acc[v].z += s * w.z; acc[v].w += s * w.w;
        }
      }
      float* mp = reinterpret_cast<float*>(p.ws + OFF_MODP);
#pragma unroll
      for (int v = 0; v < 5; ++v) *reinterpret_cast<float4*>(mp + ((size_t)(l * KS_MOD + ks) * 5 + v) * NMOD + col) = acc[v];
      __syncthreads();
    } else if (it < N_MODP + N_ROPE) {
      int idx = (it - N_MODP) * 256 + tid;
      int tl = idx >> 5, i = idx & 31;
      float inv = powf(10000.f, -(float)(i & 15) / 16.f);
      float pos = (i < 16) ? (float)(tl >> 6) : (float)(tl & 63);
      float ang = pos * inv;
      float2 cssn = make_float2(__cosf(ang), __sinf(ang));
      reinterpret_cast<float2*>(p.ws + OFF_ROPE)[idx] = cssn;
    } else {
      int idx = it - N_MODP - N_ROPE;
      conv_item(cx, p, 0, idx);
    }
  }
}

__device__ __forceinline__ void phase_modreduce(const Ctx& cx, const Params& p) {
  const float* mp = reinterpret_cast<const float*>(p.ws + OFF_MODP);
  float* mod = reinterpret_cast<float*>(p.ws + OFF_MOD);
  for (int idx = cx.vb * NT + cx.tid; idx < 2 * 5 * NMOD; idx += cx.vg * NT) {
    int col = idx % NMOD, t = idx / NMOD, v = t % 5, l = t / 5;
    float s = p.b_ada[l * NMOD + col];
    for (int ks = 0; ks < KS_MOD; ++ks) s += mp[((size_t)(l * KS_MOD + ks) * 5 + v) * NMOD + col];
    mod[idx] = s;
  }
}

struct NormArgs {
  int first;
  const bfu* y;
  const bfu* y2;
  const float* gate;
  const float* post;
  float rs;
  const float* pre;
  const float* shift;
  const float* scale;
  int write_out;
  int skip_ctx;
};
__device__ __forceinline__ void norm_phase(const Ctx& cx, const Params& p, NormArgs a) {
  const int wid = cx.tid >> 6, lane = cx.tid & 63;
  bfu* H = reinterpret_cast<bfu*>(p.ws + OFF_H);
  bfu* U = reinterpret_cast<bfu*>(p.ws + OFF_U);
  float* PL = reinterpret_cast<float*>(cx.lds);
  const int total = a.skip_ctx ? 4 * 2048 : NROW;
  const int rows_per = (total + cx.vg - 1) / cx.vg;
  const int q0 = cx.vb * rows_per, q1 = min(q0 + rows_per, total);
  auto row_of = [&](int q) { return a.skip_ctx ? ((q >> 11) * TPB + 256 + (q & 2047)) : q; };
  int v0 = 0, v1 = 0;
  if (q0 < q1) {
    const int ra = row_of(q0), rb = row_of(q1 - 1);
    v0 = (ra % TPB) < 256 ? 4 : ra / TPB;
    v1 = (rb % TPB) < 256 ? 4 : rb / TPB;
  }
  for (int i = cx.tid; i < 512; i += NT) {
    const int c = i * 4;
    if (a.y) {
      *reinterpret_cast<float4*>(PL + c) = *reinterpret_cast<const float4*>(a.post + c);
      *reinterpret_cast<float4*>(PL + 4096 + c) = *reinterpret_cast<const float4*>(a.gate + (size_t)v0 * NMOD + c);
      if (v1 != v0) *reinterpret_cast<float4*>(PL + 4096 + 6144 + c) = *reinterpret_cast<const float4*>(a.gate + (size_t)v1 * NMOD + c);
    }
    if (a.pre) {
      *reinterpret_cast<float4*>(PL + 2048 + c) = *reinterpret_cast<const float4*>(a.pre + c);
      *reinterpret_cast<float4*>(PL + 4096 + 2048 + c) = *reinterpret_cast<const float4*>(a.shift + (size_t)v0 * NMOD + c);
      *reinterpret_cast<float4*>(PL + 4096 + 4096 + c) = *reinterpret_cast<const float4*>(a.scale + (size_t)v0 * NMOD + c);
      if (v1 != v0) {
        *reinterpret_cast<float4*>(PL + 4096 + 6144 + 2048 + c) = *reinterpret_cast<const float4*>(a.shift + (size_t)v1 * NMOD + c);
        *reinterpret_cast<float4*>(PL + 4096 + 6144 + 4096 + c) = *reinterpret_cast<const float4*>(a.scale + (size_t)v1 * NMOD + c);
      }
    }
  }
  __syncthreads();
  for (int q = q0 + wid; q < q1; q += 4) {
    const int row = row_of(q);
    int b = row / TPB, t = row % TPB;
    int v = t < 256 ? 4 : b;
    const float* PS = PL + 4096 + (v == v0 ? 0 : 6144);
    float4 h[8];
    if (a.first) {
      const float* src = t < 256 ? p.ctx + ((size_t)b * 256 + t) * DM : p.x + ((size_t)b * 2048 + (t - 256)) * DM;
#pragma unroll
      for (int i = 0; i < 8; ++i) h[i] = *reinterpret_cast<const float4*>(src + i * 256 + lane * 4);
    } else {
#pragma unroll
      for (int i = 0; i < 8; ++i) {
        uint2 hb = *reinterpret_cast<const uint2*>(H + (size_t)row * DM + i * 256 + lane * 4);
        h[i].x = __uint_as_float(hb.x << 16); h[i].y = __uint_as_float(hb.x & 0xffff0000u);
        h[i].z = __uint_as_float(hb.y << 16); h[i].w = __uint_as_float(hb.y & 0xffff0000u);
      }
    }
    if (a.y) {
      float4 y[8];
      float ss = 0.f;
#pragma unroll
      for (int i = 0; i < 8; ++i) {
        {
          uint2 yb = *reinterpret_cast<const uint2*>(a.y + (size_t)row * DM + i * 256 + lane * 4);
          y[i].x = __uint_as_float(yb.x << 16); y[i].y = __uint_as_float(yb.x & 0xffff0000u);
          y[i].z = __uint_as_float(yb.y << 16); y[i].w = __uint_as_float(yb.y & 0xffff0000u);
        }
        if (a.y2) {
          uint2 yb = *reinterpret_cast<const uint2*>(a.y2 + (size_t)row * DM + i * 256 + lane * 4);
          y[i].x += __uint_as_float(yb.x << 16); y[i].y += __uint_as_float(yb.x & 0xffff0000u);
          y[i].z += __uint_as_float(yb.y << 16); y[i].w += __uint_as_float(yb.y & 0xffff0000u);
        }
        ss += y[i].x * y[i].x + y[i].y * y[i].y + y[i].z * y[i].z + y[i].w * y[i].w;
      }
      ss = wave_sum(ss);
      float ry = rsqrtf(ss * (1.f / DM) + EPS) * a.rs;
#pragma unroll
      for (int i = 0; i < 8; ++i) {
        int c = i * 256 + lane * 4;
        float4 g = *reinterpret_cast<const float4*>(PS + c);
        float4 po = *reinterpret_cast<const float4*>(PL + c);
        h[i].x += g.x * (y[i].x * ry * po.x);
        h[i].y += g.y * (y[i].y * ry * po.y);
        h[i].z += g.z * (y[i].z * ry * po.z);
        h[i].w += g.w * (y[i].w * ry * po.w);
      }
    }
    if (a.first || a.y) {
#pragma unroll
      for (int i = 0; i < 8; ++i) {
        uint2 hb; hb.x = pack2(h[i].x, h[i].y); hb.y = pack2(h[i].z, h[i].w);
        *reinterpret_cast<uint2*>(H + (size_t)row * DM + i * 256 + lane * 4) = hb;
      }
    }
    if (a.write_out && t >= 256) {
      float* o = p.out + ((size_t)b * 2048 + (t - 256)) * DM;
#pragma unroll
      for (int i = 0; i < 8; ++i) *reinterpret_cast<float4*>(o + i * 256 + lane * 4) = h[i];
    }
    if (a.pre) {
      float ss = 0.f;
#pragma unroll
      for (int i = 0; i < 8; ++i) ss += h[i].x * h[i].x + h[i].y * h[i].y + h[i].z * h[i].z + h[i].w * h[i].w;
      ss = wave_sum(ss);
      float rh = rsqrtf(ss * (1.f / DM) + EPS);
#pragma unroll
      for (int i = 0; i < 8; ++i) {
        int c = i * 256 + lane * 4;
        float4 pr = *reinterpret_cast<const float4*>(PL + 2048 + c);
        float4 sh = *reinterpret_cast<const float4*>(PS + 2048 + c);
        float4 sc = *reinterpret_cast<const float4*>(PS + 4096 + c);
        uint2 o;
        o.x = pack2((h[i].x * rh * pr.x) * (1.f + sc.x) + sh.x, (h[i].y * rh * pr.y) * (1.f + sc.y) + sh.y);
        o.y = pack2((h[i].z * rh * pr.z) * (1.f + sc.z) + sh.z, (h[i].w * rh * pr.w) * (1.f + sc.w) + sh.w);
        *reinterpret_cast<uint2*>(U + (size_t)row * DM + c) = o;
      }
    }
  }
}

__device__ __forceinline__ float lower_bound(const Params& p, int l, int dir, int c) {
  if (l == 0) return 0.f;
  float a0 = p.lb_logits[(0 * 2 + dir) * 512 + c], a1 = p.lb_logits[(1 * 2 + dir) * 512 + c];
  float mx = fmaxf(a0, a1);
  float e0 = __expf(a0 - mx), e1 = __expf(a1 - mx);
  return e1 / (e0 + e1);
}

using bf16x4 = __attribute__((ext_vector_type(4))) short;
__device__ __forceinline__ f32x4 mfma16k(bf16x4 a, bf16x4 b, f32x4 c, int, int, int) {
  const bf16x8 a8 = (bf16x8){a[0], a[1], a[2], a[3], 0, 0, 0, 0};
  const bf16x8 b8 = (bf16x8){b[0], b[1], b[2], b[3], 0, 0, 0, 0};
  return __builtin_amdgcn_mfma_f32_16x16x32_bf16(a8, b8, c, 0, 0, 0);
}
__device__ __forceinline__ bfu f2bf_hw(float x) { return (bfu)(pack2(x, x) & 0xffffu); }

__device__ __forceinline__ void gla_pass1(const Ctx& cx, const Params& p, int l, int item, float* ldsf, int lane) {
  int n = item % 36, t = item / 36;
  int dir = t & 1; t >>= 1;
  int h = t & 7; t >>= 3;
  int b = t & 3, m = t >> 2;
  int tb = dir == 0 ? n : (n < 4 ? 3 - n : 39 - n);
  const float* z = reinterpret_cast<const float*>(p.ws + OFF_Z);
  const bfu* zb_ = reinterpret_cast<const bfu*>(p.ws + OFF_ZB);
  const int rowbase = b * TPB + tb * 64;
  const int hc = h * 64 + lane;
  const int c = lane & 15, g = lane >> 4;
  const float lb = (m == 0) ? lower_bound(p, l, dir, hc) : 0.f;
  const float fconst = 1.f - exp2f(-5.f - (float)h);
  const int c0off = (m == 0) ? (dir ? 1024 : 512) : 3072;
  const int c1off = (m == 0) ? 1536 : 3584;
  char* L = reinterpret_cast<char*>(ldsf);
  bfu* KTs = reinterpret_cast<bfu*>(L + 4352);
  bfu* VTs = reinterpret_cast<bfu*>(L + 6912);
  float* gs = reinterpret_cast<float*>(L + 9472);
  f32x4 T[4][4];
#pragma unroll
  for (int db = 0; db < 4; ++db)
#pragma unroll
    for (int vb = 0; vb < 4; ++vb) T[db][vb] = (f32x4){0.f, 0.f, 0.f, 0.f};
  float gacc = 1.f;
  float r0[16], r1[16];
#pragma unroll
  for (int i = 0; i < 16; ++i) {
    int tok = dir ? 63 - i : i;
    const float* zr = z + (size_t)(rowbase + tok) * INW;
    const bfu* zbr = zb_ + (size_t)(rowbase + tok) * INW;
    r0[i] = (m == 0) ? zr[c0off + hc] : ldb(zbr + c0off + hc);
    r1[i] = ldb(zbr + c1off + hc);
  }
#pragma unroll 1
  for (int sub = 0; sub < 4; ++sub) {
    {
      float kt[16];
      float e = 1.f;
#pragma unroll
      for (int i = 0; i < 16; ++i) {
        float f, k;
        if (m == 0) { f = r0[i]; k = 1.f - f; }
        else { f = fconst; k = r0[i]; }
        e = fmaxf(e * f, 1e-26f);
        kt[i] = k * __builtin_amdgcn_rcpf(e);
      }
      const float gdec = e;
      gacc *= gdec;
      gs[lane] = gdec;
#pragma unroll
      for (int q = 0; q < 4; ++q) {
        u32x2 kk, vv;
        kk.x = pack2(kt[4 * q] * gdec, kt[4 * q + 1] * gdec); kk.y = pack2(kt[4 * q + 2] * gdec, kt[4 * q + 3] * gdec);
        vv.x = pack2(r1[4 * q], r1[4 * q + 1]); vv.y = pack2(r1[4 * q + 2], r1[4 * q + 3]);
        *reinterpret_cast<u32x2*>(KTs + lane * 20 + 4 * q) = kk;
        *reinterpret_cast<u32x2*>(VTs + lane * 20 + 4 * q) = vv;
      }
    }
    wave_fence();
    if (sub < 3) {
#pragma unroll
      for (int i = 0; i < 16; ++i) {
        int s = (sub + 1) * 16 + i;
        int tok = dir ? 63 - s : s;
        const float* zr = z + (size_t)(rowbase + tok) * INW;
        const bfu* zbr = zb_ + (size_t)(rowbase + tok) * INW;
        r0[i] = (m == 0) ? zr[c0off + hc] : ldb(zbr + c0off + hc);
        r1[i] = ldb(zbr + c1off + hc);
      }
    }
    {
      bf16x4 vA[4];
#pragma unroll
      for (int vb = 0; vb < 4; ++vb) vA[vb] = __builtin_bit_cast(bf16x4, *reinterpret_cast<const u32x2*>(VTs + (16 * vb + c) * 20 + 4 * g));
#pragma unroll
      for (int db = 0; db < 4; ++db) {
        const f32x4 g4 = *reinterpret_cast<const f32x4*>(gs + 16 * db + 4 * g);
        const bf16x4 ktA = __builtin_bit_cast(bf16x4, *reinterpret_cast<const u32x2*>(KTs + (16 * db + c) * 20 + 4 * g));
#pragma unroll
        for (int vb = 0; vb < 4; ++vb) T[db][vb] = mfma16k(ktA, vA[vb], T[db][vb] * g4, 0, 0, 0);
      }
    }
    wave_fence();
  }
  bfu* U = reinterpret_cast<bfu*>(p.ws + OFF_GU) + (size_t)item * 4096;
#pragma unroll
  for (int db = 0; db < 4; ++db)
#pragma unroll
    for (int vb = 0; vb < 4; ++vb) {
      const f32x4 tv = T[db][vb];
      *reinterpret_cast<u32x2*>(U + (16 * vb + c) * 64 + 16 * db + 4 * g) = (u32x2){pack2(tv[0], tv[1]), pack2(tv[2], tv[3])};
    }
  reinterpret_cast<float*>(p.ws + OFF_GG)[(size_t)item * 64 + lane] = gacc;
}

__device__ __forceinline__ void gla_pass2(const Ctx& cx, const Params& p) {
  unsigned* U = reinterpret_cast<unsigned*>(p.ws + OFF_GU);
  const float* G = reinterpret_cast<const float*>(p.ws + OFF_GG);
  for (int idx = cx.vb * NT + cx.tid; idx < 128 * 2048; idx += cx.vg * NT) {
    const int c = idx >> 11, e2 = idx & 2047, d0 = (2 * e2) & 63;
    float S0 = 0.f, S1 = 0.f;
    for (int n = 0; n < 36; ++n) {
      const size_t o = ((size_t)(c * 36 + n) << 11) + e2;
      const unsigned uu = U[o];
      const float2 gg = *reinterpret_cast<const float2*>(G + (size_t)(c * 36 + n) * 64 + d0);
      U[o] = pack2(S0, S1);
      S0 = gg.x * S0 + __uint_as_float(uu << 16);
      S1 = gg.y * S1 + __uint_as_float(uu & 0xffff0000u);
    }
  }
}

__device__ __forceinline__ void gla_pass3(const Ctx& cx, const Params& p, int l, int item, float* ldsf, int lane) {
  int tb, t;
  if (l == 1) { tb = 4 + (item & 31); t = item >> 5; } else { tb = item % 36; t = item / 36; }
  int h = t & 7; t >>= 3;
  int b = t & 3, m = t >> 2;
  const float* z = reinterpret_cast<const float*>(p.ws + OFF_Z);
  const bfu* zb_ = reinterpret_cast<const bfu*>(p.ws + OFF_ZB);
  bfu* ofwd = reinterpret_cast<bfu*>(p.ws + OFF_OFWD);
  bfu* mix = reinterpret_cast<bfu*>(p.ws + OFF_MIX);
  const int rowbase = b * TPB + tb * 64;
  const int hc = h * 64 + lane;
  const int c = lane & 15, g = lane >> 4;
  const int dg = g, vg = c;
  const int ocol = m * 512 + h * 64 + vg * 4;
  const f32x4 gain4 = *reinterpret_cast<const f32x4*>((m == 0 ? p.a_norm : p.b_norm) + l * 64 + vg * 4);
  const float fconst = 1.f - exp2f(-5.f - (float)h);
  const int cqoff = (m == 0) ? 0 : 2560;
  const int cvoff = (m == 0) ? 1536 : 3584;
  const int cgoff = (m == 0) ? 2048 : 4096;
  char* L = reinterpret_cast<char*>(ldsf);
  bfu* Qs = reinterpret_cast<bfu*>(L);
  bfu* Ks = reinterpret_cast<bfu*>(L + 2176);
  bfu* KTs = reinterpret_cast<bfu*>(L + 4352);
  bfu* VTs = reinterpret_cast<bfu*>(L + 6912);
  float* gs = reinterpret_cast<float*>(L + 9472);
#pragma unroll 1
  for (int dir = 0; dir < 2; ++dir) {
    int n = dir == 0 ? tb : (tb < 4 ? 3 - tb : 39 - tb);
    int chain = ((m * 4 + b) * 8 + h) * 2 + dir;
    const bfu* Sp = reinterpret_cast<const bfu*>(p.ws + OFF_GU) + ((size_t)(chain * 36 + n) << 12);
    const float lb = (m == 0) ? lower_bound(p, l, dir, hc) : 0.f;
    const int cfoff = (m == 0) ? (dir ? 1024 : 512) : 3072;
    f32x4 T[4][4];
#pragma unroll
    for (int db = 0; db < 4; ++db)
#pragma unroll
      for (int vb = 0; vb < 4; ++vb) {
        const u32x2 sv = *reinterpret_cast<const u32x2*>(Sp + (16 * vb + c) * 64 + 16 * db + 4 * g);
        T[db][vb] = (f32x4){__uint_as_float(sv.x << 16), __uint_as_float(sv.x & 0xffff0000u), __uint_as_float(sv.y << 16), __uint_as_float(sv.y & 0xffff0000u)};
      }
    float r0[16], r1[16], r2[16];
#pragma unroll
    for (int i = 0; i < 16; ++i) {
      int tok = dir ? 63 - i : i;
      const float* zr = z + (size_t)(rowbase + tok) * INW;
      const bfu* zbr = zb_ + (size_t)(rowbase + tok) * INW;
      r0[i] = (m == 0) ? zr[cfoff + hc] : ldb(zbr + cfoff + hc);
      r1[i] = ldb(zbr + cqoff + hc);
      r2[i] = ldb(zbr + cvoff + hc);
    }
#pragma unroll 1
    for (int sub = 0; sub < 4; ++sub) {
      {
        float kt[16];
        float e = 1.f;
#pragma unroll
        for (int i = 0; i < 16; ++i) {
          float f, k, q;
          if (m == 0) { f = r0[i]; k = 1.f - f; q = r1[i]; }
          else { f = fconst; k = r0[i]; q = r1[i]; }
          e = fmaxf(e * f, 1e-26f);
          const float ie = __builtin_amdgcn_rcpf(e);
          kt[i] = k * ie;
          Qs[i * 68 + lane] = f2bf_hw(q * e);
          Ks[i * 68 + lane] = f2bf_hw(kt[i]);
        }
        const float gdec = e;
        gs[lane] = gdec;
#pragma unroll
        for (int q = 0; q < 4; ++q) {
          u32x2 kk, vv;
          kk.x = pack2(kt[4 * q] * gdec, kt[4 * q + 1] * gdec); kk.y = pack2(kt[4 * q + 2] * gdec, kt[4 * q + 3] * gdec);
          vv.x = pack2(r2[4 * q], r2[4 * q + 1]); vv.y = pack2(r2[4 * q + 2], r2[4 * q + 3]);
          *reinterpret_cast<u32x2*>(KTs + lane * 20 + 4 * q) = kk;
          *reinterpret_cast<u32x2*>(VTs + lane * 20 + 4 * q) = vv;
        }
      }
      wave_fence();
      if (sub < 3) {
#pragma unroll
        for (int i = 0; i < 16; ++i) {
          int s = (sub + 1) * 16 + i;
          int tok = dir ? 63 - s : s;
          const float* zr = z + (size_t)(rowbase + tok) * INW;
          const bfu* zbr = zb_ + (size_t)(rowbase + tok) * INW;
          r0[i] = (m == 0) ? zr[cfoff + hc] : ldb(zbr + cfoff + hc);
          r1[i] = ldb(zbr + cqoff + hc);
          r2[i] = ldb(zbr + cvoff + hc);
        }
      }
      {
        bf16x8 qB[2], kA[2];
#pragma unroll
        for (int ks = 0; ks < 2; ++ks) {
          const u32x2 qlo = *reinterpret_cast<const u32x2*>(Qs + c * 68 + 32 * ks + 4 * g);
          const u32x2 qhi = *reinterpret_cast<const u32x2*>(Qs + c * 68 + 32 * ks + 16 + 4 * g);
          const u32x2 klo = *reinterpret_cast<const u32x2*>(Ks + c * 68 + 32 * ks + 4 * g);
          const u32x2 khi = *reinterpret_cast<const u32x2*>(Ks + c * 68 + 32 * ks + 16 + 4 * g);
          qB[ks] = __builtin_bit_cast(bf16x8, (u32x4){qlo.x, qlo.y, qhi.x, qhi.y});
          kA[ks] = __builtin_bit_cast(bf16x8, (u32x4){klo.x, klo.y, khi.x, khi.y});
        }
        f32x4 AT = (f32x4){0.f, 0.f, 0.f, 0.f};
        AT = __builtin_amdgcn_mfma_f32_16x16x32_bf16(kA[0], qB[0], AT, 0, 0, 0);
        AT = __builtin_amdgcn_mfma_f32_16x16x32_bf16(kA[1], qB[1], AT, 0, 0, 0);
#pragma unroll
        for (int r = 0; r < 4; ++r) AT[r] = (4 * g + r <= c) ? AT[r] : 0.f;
        const bf16x4 pB = __builtin_bit_cast(bf16x4, (u32x2){pack2(AT[0], AT[1]), pack2(AT[2], AT[3])});
        bf16x4 vA[4];
#pragma unroll
        for (int vb = 0; vb < 4; ++vb) vA[vb] = __builtin_bit_cast(bf16x4, *reinterpret_cast<const u32x2*>(VTs + (16 * vb + c) * 20 + 4 * g));
        const int tokc = dir ? 63 - (sub * 16 + c) : (sub * 16 + c);
        bfu* orow = ofwd + ((size_t)dir * NROW + (size_t)(rowbase + tokc)) * 1024 + m * 512 + h * 64 + 4 * g;
#pragma unroll
        for (int vb = 0; vb < 4; ++vb) {
          f32x4 OT = (f32x4){0.f, 0.f, 0.f, 0.f};
          OT = mfma16k(vA[vb], pB, OT, 0, 0, 0);
#pragma unroll
          for (int ks = 0; ks < 2; ++ks) {
            const u32x4 sp = (u32x4){pack2(T[2 * ks][vb][0], T[2 * ks][vb][1]), pack2(T[2 * ks][vb][2], T[2 * ks][vb][3]),
                                     pack2(T[2 * ks + 1][vb][0], T[2 * ks + 1][vb][1]), pack2(T[2 * ks + 1][vb][2], T[2 * ks + 1][vb][3])};
            OT = __builtin_amdgcn_mfma_f32_16x16x32_bf16(__builtin_bit_cast(bf16x8, sp), qB[ks], OT, 0, 0, 0);
          }
          *reinterpret_cast<u32x2*>(orow + 16 * vb) = (u32x2){pack2(OT[0], OT[1]), pack2(OT[2], OT[3])};
        }
#pragma unroll
        for (int db = 0; db < 4; ++db) {
          const f32x4 g4 = *reinterpret_cast<const f32x4*>(gs + 16 * db + 4 * g);
          const bf16x4 ktA = __builtin_bit_cast(bf16x4, *reinterpret_cast<const u32x2*>(KTs + (16 * db + c) * 20 + 4 * g));
#pragma unroll
          for (int vb = 0; vb < 4; ++vb) T[db][vb] = mfma16k(ktA, vA[vb], T[db][vb] * g4, 0, 0, 0);
        }
      }
      wave_fence();
    }
  }
  asm volatile("s_waitcnt vmcnt(0)" ::: "memory");
#pragma unroll 1
  for (int i0 = 0; i0 < 16; i0 += 8) {
    f32x4 of[8], ob[8], gz[8];
#pragma unroll
    for (int i = 0; i < 8; ++i) {
      const size_t row = (size_t)(rowbase + dg + 4 * (i0 + i));
      {
        const u32x2 a2 = *reinterpret_cast<const u32x2*>(ofwd + row * 1024 + ocol);
        const u32x2 b2 = *reinterpret_cast<const u32x2*>(ofwd + ((size_t)NROW + row) * 1024 + ocol);
        of[i] = (f32x4){__uint_as_float(a2.x << 16), __uint_as_float(a2.x & 0xffff0000u), __uint_as_float(a2.y << 16), __uint_as_float(a2.y & 0xffff0000u)};
        ob[i] = (f32x4){__uint_as_float(b2.x << 16), __uint_as_float(b2.x & 0xffff0000u), __uint_as_float(b2.y << 16), __uint_as_float(b2.y & 0xffff0000u)};
      }
      {
        const u32x2 g2 = *reinterpret_cast<const u32x2*>(zb_ + row * INW + cgoff + h * 64 + vg * 4);
        gz[i] = (f32x4){__uint_as_float(g2.x << 16), __uint_as_float(g2.x & 0xffff0000u), __uint_as_float(g2.y << 16), __uint_as_float(g2.y & 0xffff0000u)};
      }
    }
#pragma unroll
    for (int i = 0; i < 8; ++i) {
      const size_t row = (size_t)(rowbase + dg + 4 * (i0 + i));
      const f32x4 o4 = of[i] + ob[i];
      float ss = o4[0] * o4[0] + o4[1] * o4[1] + o4[2] * o4[2] + o4[3] * o4[3];
      ss += __shfl_xor(ss, 1);
      ss += __shfl_xor(ss, 2);
      ss += __shfl_xor(ss, 4);
      ss += __shfl_xor(ss, 8);
      const float rn = rsqrtf(ss * (1.f / 64.f) + EPS);
      uint2 o;
      o.x = pack2(o4[0] * rn * gain4[0] * gz[i][0], o4[1] * rn * gain4[1] * gz[i][1]);
      o.y = pack2(o4[2] * rn * gain4[2] * gz[i][2], o4[3] * rn * gain4[3] * gz[i][3]);
      *reinterpret_cast<uint2*>(mix + row * DM + ocol) = o;
    }
  }
}

__device__ __forceinline__ void rg_load_w(const Ctx& cx, const Params& p, int l, int g) {
  bfu* wl = reinterpret_cast<bfu*>(cx.lds + 26624);
  const int c = cx.tid & 63, tq = cx.tid >> 6;
#pragma unroll
  for (int t = 0; t < 4; ++t) {
    const float* w = ((t & 1) ? p.d_w_i : p.d_w_r) + ((size_t)(l * 2 + (t >> 1)) * 8 + g) * 4096 + c;
#pragma unroll
    for (int ii = 0; ii < 16; ++ii) {
      const int i = tq * 16 + ii;
      wl[(t * 64 + c) * 72 + i] = f2bf_hw(w[i * 64]);
    }
  }
}

__device__ __forceinline__ void rg_d1(const Ctx& cx, const Params& p, int l, int item) {
  char* smem = cx.lds;
  float* xcf = reinterpret_cast<float*>(smem);
  bfu* xcb = reinterpret_cast<bfu*>(smem + 17408);
  const bfu* wl = reinterpret_cast<const bfu*>(smem + 26624);
  int g = item & 7, t = item >> 3;
  int tb = t % 36, b = t / 36;
  const int tid = cx.tid, c = tid & 63, tq = tid >> 6;
  const float* z = reinterpret_cast<const float*>(p.ws + OFF_Z);
  const bfu* zb_ = reinterpret_cast<const bfu*>(p.ws + OFF_ZB);
  const int seg_lo = tb < 4 ? 0 : 256, seg_hi = tb < 4 ? 256 : TPB;
  {
    const int ch = g * 64 + c;
    float cw[4];
#pragma unroll
    for (int j = 0; j < 4; ++j) cw[j] = p.d_conv_w[(l * 4 + j) * 512 + ch];
    const float cb = p.d_conv_b[l * 512 + ch];
    const int tok0 = tb * 64 + tq * 16;
    float win[19];
#pragma unroll
    for (int i = 0; i < 19; ++i) {
      int tt = tok0 - 1 + i;
      win[i] = (tt >= seg_lo && tt < seg_hi) ? ldb(zb_ + (size_t)(b * TPB + tt) * INW + 6144 + ch) : 0.f;
    }
#pragma unroll
    for (int i = 0; i < 16; ++i) {
      const float x = cb + cw[0] * win[i] + cw[1] * win[i + 1] + cw[2] * win[i + 2] + cw[3] * win[i + 3];
      xcf[(tq * 16 + i) * 68 + c] = x;
      xcb[(tq * 16 + i) * 72 + c] = f2bf_hw(x);
    }
  }
  __syncthreads();
  const int lane = tid & 63, c16 = lane & 15, g4 = lane >> 4;
  f32x4 pre[4][4];
  {
    bf16x8 aF[2];
#pragma unroll
    for (int ks = 0; ks < 2; ++ks) aF[ks] = *reinterpret_cast<const bf16x8*>(xcb + (tq * 16 + c16) * 72 + ks * 32 + g4 * 8);
#pragma unroll
    for (int ty = 0; ty < 4; ++ty)
#pragma unroll
      for (int cbk = 0; cbk < 4; ++cbk) {
        f32x4 acc = (f32x4){0.f, 0.f, 0.f, 0.f};
#pragma unroll
        for (int ks = 0; ks < 2; ++ks) {
          const bf16x8 bF = *reinterpret_cast<const bf16x8*>(wl + ((ty * 4 + cbk) * 16 + c16) * 72 + ks * 32 + g4 * 8);
          acc = __builtin_amdgcn_mfma_f32_16x16x32_bf16(aF[ks], bF, acc, 0, 0, 0);
        }
        pre[ty][cbk] = acc;
      }
  }
  unsigned* AU = reinterpret_cast<unsigned*>(p.ws + OFF_AU);
  float2* PH = reinterpret_cast<float2*>(p.ws + OFF_PH);
  const int tb16 = tb * 4 + tq;
  const int row0 = b * TPB + tb * 64 + tq * 16 + 4 * g4;
#pragma unroll
  for (int cbk = 0; cbk < 4; ++cbk) {
    const int ch = g * 64 + cbk * 16 + c16;
    float xc[4];
#pragma unroll
    for (int r = 0; r < 4; ++r) xc[r] = xcf[(tq * 16 + 4 * g4 + r) * 68 + cbk * 16 + c16];
#pragma unroll
    for (int dir = 0; dir < 2; ++dir) {
      const float br = p.d_b_r[(l * 2 + dir) * 512 + ch], bi = p.d_b_i[(l * 2 + dir) * 512 + ch];
      const float lam = p.d_lambda[(l * 2 + dir) * 512 + ch];
      const float sp = log1pf(__expf(-lam));
      float av[4], uv[4];
#pragma unroll
      for (int r = 0; r < 4; ++r) {
        const float rr = sigmoidf_(pre[dir * 2][cbk][r] + br);
        const float ig = sigmoidf_(pre[dir * 2 + 1][cbk][r] + bi);
        const float la = -8.f * rr * sp;
        av[r] = __expf(la);
        const float y = -2.f * la;
        float om;
        if (y < 0.25f) om = y * (1.f + y * (-0.5f + y * (0.16666667f + y * (-0.041666668f + y * 0.008333334f))));
        else om = -expm1f(-y);
        uv[r] = sqrtf(om) * (ig * xc[r]);
        {
          const float yl = -la;
          const float oma = (yl < 0.25f) ? yl * (1.f + yl * (-0.5f + yl * (0.16666667f + yl * (-0.041666668f + yl * 0.008333334f)))) : (1.f - av[r]);
          AU[((size_t)dir * NROW + row0 + r) * 512 + ch] = pack2(oma, uv[r]);
        }
      }
      float P4 = 1.f, H4 = 0.f;
#pragma unroll
      for (int s4 = 0; s4 < 4; ++s4) {
        const int r = dir ? 3 - s4 : s4;
        H4 = av[r] * H4 + uv[r];
        P4 *= av[r];
      }
      float P = 1.f, Hh = 0.f;
#pragma unroll
      for (int s4 = 0; s4 < 4; ++s4) {
        const int k = dir ? 3 - s4 : s4;
        const float Pk = __shfl(P4, c16 + 16 * k);
        const float Hk = __shfl(H4, c16 + 16 * k);
        Hh = Pk * Hh + Hk;
        P *= Pk;
      }
      const int n = dir == 0 ? tb16 : (tb16 < 16 ? 15 - tb16 : 159 - tb16);
      if (g4 == 0) PH[((size_t)(b * 2 + dir) * 144 + n) * 512 + ch] = make_float2(P, Hh);
    }
  }
  __syncthreads();
}

__device__ __forceinline__ void rg_d2(const Ctx& cx, const Params& p) {
  float2* PH = reinterpret_cast<float2*>(p.ws + OFF_PH);
  for (int idx = cx.vb * NT + cx.tid; idx < 4096; idx += cx.vg * NT) {
    int ch = idx & 511, bd = idx >> 9;
    float h = 0.f;
    for (int n = 0; n < 144; ++n) {
      size_t o = ((size_t)bd * 144 + n) * 512 + ch;
      float2 ph = PH[o];
      PH[o].y = h;
      h = ph.x * h + ph.y;
    }
  }
}

__device__ __forceinline__ void rg_d3(const Ctx& cx, const Params& p, int l, int idx) {
  const unsigned* AU = reinterpret_cast<const unsigned*>(p.ws + OFF_AU);
  const float2* PH = reinterpret_cast<const float2*>(p.ws + OFF_PH);
  const float* z = reinterpret_cast<const float*>(p.ws + OFF_Z);
  const bfu* zb_ = reinterpret_cast<const bfu*>(p.ws + OFF_ZB);
  bfu* mix = reinterpret_cast<bfu*>(p.ws + OFF_MIX);
  int ch = idx & 511, rg = idx >> 9;
  int b = rg / 144, tb16 = rg % 144;
  if (l == 1 && tb16 < 16) return;
  int row0 = b * TPB + tb16 * 16;
  float hf[16];
  float h = PH[((size_t)(b * 2 + 0) * 144 + tb16) * 512 + ch].y;
#pragma unroll
  for (int i = 0; i < 16; ++i) {
    const unsigned au = AU[((size_t)(row0 + i)) * 512 + ch];
    h = (1.f - __uint_as_float(au << 16)) * h + __uint_as_float(au & 0xffff0000u);
    hf[i] = h;
  }
  int n = tb16 < 16 ? 15 - tb16 : 159 - tb16;
  h = PH[((size_t)(b * 2 + 1) * 144 + n) * 512 + ch].y;
#pragma unroll
  for (int s = 0; s < 16; ++s) {
    int i = 15 - s;
    const unsigned au = AU[((size_t)NROW + row0 + i) * 512 + ch];
    h = (1.f - __uint_as_float(au << 16)) * h + __uint_as_float(au & 0xffff0000u);
    float gz = ldb(zb_ + (size_t)(row0 + i) * INW + 6656 + ch);
    mix[(size_t)(row0 + i) * DM + 1536 + ch] = f2bf(gz * (hf[i] + h));
  }
}

__device__ __forceinline__ void attn_item(const int tid, char* smem, const Params& p, int l, int item) {
  char* Ks = smem;
  char* Vs = smem + 18432;
  const int wid = tid >> 6, lane = tid & 63, fr = lane & 15, fq = lane >> 4;
  int qt, bh;
  if (item < 256) { const int x = item & 7, j = item >> 3; bh = x * 2 + (j >> 4); qt = 2 + (j & 15); }
  else { const int r = item - 256, x = r & 7, j = r >> 3; bh = x * 2 + (j >> 1); qt = j & 1; }
  const int hd = bh & 3, b = bh >> 2;
  const int nkt = qt < 2 ? 4 : 36;
  const bfu* Qc = reinterpret_cast<const bfu*>(p.ws + OFF_QC);
  const bfu* Kc = reinterpret_cast<const bfu*>(p.ws + OFF_KC);
  const bfu* Vt = reinterpret_cast<const bfu*>(p.ws + OFF_VT);
  bfu* mix = reinterpret_cast<bfu*>(p.ws + OFF_MIX);
  const float* lv = p.c_lambda + l * 256;
  float d1 = wave_sum(lv[lane] * lv[64 + lane]);
  float d2 = wave_sum(lv[128 + lane] * lv[192 + lane]);
  const float lam_init = 0.8f - 0.6f * expf(-0.3f * (float)l);
  const float lam = expf(d1) - expf(d2) + lam_init;

  const int qrow = b * TPB + qt * 128 + wid * 16 + fr;
  const bfu* qp = Qc + (size_t)qrow * 512 + hd * 128;
  bf16x8 qf[2][2];
#pragma unroll
  for (int h = 0; h < 2; ++h)
#pragma unroll
    for (int ks = 0; ks < 2; ++ks) qf[h][ks] = *reinterpret_cast<const bf16x8*>(qp + h * 64 + ks * 32 + fq * 8);
  f32x4 O[2][8];
#pragma unroll
  for (int h = 0; h < 2; ++h)
#pragma unroll
    for (int vb = 0; vb < 8; ++vb) O[h][vb] = (f32x4){0.f, 0.f, 0.f, 0.f};
  float mrun[2] = {-INFINITY, -INFINITY}, lrun[2] = {0.f, 0.f};

  const bfu* kbase = Kc + (size_t)(b * TPB) * 512 + hd * 128;
  const bfu* vbase = Vt + ((size_t)b * 512 + hd * 128) * TPB;
  const unsigned koff0 = (unsigned)((tid >> 4) * 512 + (tid & 15) * 8), koff1 = koff0 + 32u * 512u;
  const unsigned voff0 = (unsigned)((tid >> 3) * TPB + (tid & 7) * 8), voff1 = voff0 + 64u * (unsigned)TPB;
  const int kl0 = (tid >> 4) * 288 + (tid & 15) * 16;
  const int vq = tid & 7;
  const int vl0 = (tid >> 3) * 288 + ((vq >> 2) * 32 + 2 * (vq & 1) * 8 + ((vq >> 1) & 1) * 4) * 2;
  constexpr int ABUF = 55296;
  u32x4 kr0 = *reinterpret_cast<const u32x4*>(kbase + koff0), kr1 = *reinterpret_cast<const u32x4*>(kbase + koff1);
  u32x4 vr0 = *reinterpret_cast<const u32x4*>(vbase + voff0), vr1 = *reinterpret_cast<const u32x4*>(vbase + voff1);
  __syncthreads();
  *reinterpret_cast<u32x4*>(Ks + kl0) = kr0;
  *reinterpret_cast<u32x4*>(Ks + kl0 + 32 * 288) = kr1;
  *reinterpret_cast<u32x2*>(Vs + vl0) = (u32x2){vr0.x, vr0.y};
  *reinterpret_cast<u32x2*>(Vs + vl0 + 16) = (u32x2){vr0.z, vr0.w};
  *reinterpret_cast<u32x2*>(Vs + vl0 + 64 * 288) = (u32x2){vr1.x, vr1.y};
  *reinterpret_cast<u32x2*>(Vs + vl0 + 64 * 288 + 16) = (u32x2){vr1.z, vr1.w};
  if (nkt > 1) {
    const bfu* kb_ = kbase + (size_t)64 * 512;
    const bfu* vb_ = vbase + 64;
    kr0 = *reinterpret_cast<const u32x4*>(kb_ + koff0); kr1 = *reinterpret_cast<const u32x4*>(kb_ + koff1);
    vr0 = *reinterpret_cast<const u32x4*>(vb_ + voff0); vr1 = *reinterpret_cast<const u32x4*>(vb_ + voff1);
  }
  __syncthreads();
  char* const Ks0 = Ks; char* const Vs0 = Vs;
#pragma unroll 1
  for (int kt = 0; kt < nkt; ++kt) {
    if (kt + 1 < nkt) {
      char* Kd = Ks0 + ((kt + 1) & 1) * ABUF; char* Vd = Vs0 + ((kt + 1) & 1) * ABUF;
      *reinterpret_cast<u32x4*>(Kd + kl0) = kr0;
      *reinterpret_cast<u32x4*>(Kd + kl0 + 32 * 288) = kr1;
      *reinterpret_cast<u32x2*>(Vd + vl0) = (u32x2){vr0.x, vr0.y};
      *reinterpret_cast<u32x2*>(Vd + vl0 + 16) = (u32x2){vr0.z, vr0.w};
      *reinterpret_cast<u32x2*>(Vd + vl0 + 64 * 288) = (u32x2){vr1.x, vr1.y};
      *reinterpret_cast<u32x2*>(Vd + vl0 + 64 * 288 + 16) = (u32x2){vr1.z, vr1.w};
    }
    if (kt + 2 < nkt) {
      const bfu* kb_ = kbase + (size_t)(kt + 2) * 64 * 512;
      const bfu* vb_ = vbase + (kt + 2) * 64;
      kr0 = *reinterpret_cast<const u32x4*>(kb_ + koff0); kr1 = *reinterpret_cast<const u32x4*>(kb_ + koff1);
      vr0 = *reinterpret_cast<const u32x4*>(vb_ + voff0); vr1 = *reinterpret_cast<const u32x4*>(vb_ + voff1);
    }
    Ks = Ks0 + (kt & 1) * ABUF; Vs = Vs0 + (kt & 1) * ABUF;
    f32x4 S[2][4];
#pragma unroll
    for (int h = 0; h < 2; ++h)
#pragma unroll
      for (int kb = 0; kb < 4; ++kb) {
        f32x4 s = (f32x4){0.f, 0.f, 0.f, 0.f};
#pragma unroll
        for (int ks = 0; ks < 2; ++ks) {
          bf16x8 kf = *reinterpret_cast<const bf16x8*>(Ks + (kb * 16 + fr) * 288 + (h * 64 + ks * 32 + fq * 8) * 2);
          s = __builtin_amdgcn_mfma_f32_16x16x32_bf16(kf, qf[h][ks], s, 0, 0, 0);
        }
        S[h][kb] = s;
      }
    bf16x8 pf[2][2];
#pragma unroll
    for (int h = 0; h < 2; ++h) {
      float mx = -INFINITY;
#pragma unroll
      for (int kb = 0; kb < 4; ++kb)
#pragma unroll
        for (int r = 0; r < 4; ++r) mx = fmaxf(mx, S[h][kb][r]);
      mx = fmaxf(mx, __shfl_xor(mx, 16));
      mx = fmaxf(mx, __shfl_xor(mx, 32));
      const float mold = mrun[h];
      const float mnew = fmaxf(mold, mx);
      mrun[h] = mnew;
      float ps = 0.f;
      float pv[4][4];
#pragma unroll
      for (int kb = 0; kb < 4; ++kb)
#pragma unroll
        for (int r = 0; r < 4; ++r) {
          pv[kb][r] = __builtin_amdgcn_exp2f(S[h][kb][r] - mnew);
          ps += pv[kb][r];
        }
      if (__builtin_amdgcn_ballot_w64(mnew > mold) != 0ull) {
        const float alpha = __builtin_amdgcn_exp2f(mold - mnew);
        lrun[h] *= alpha;
#pragma unroll
        for (int vb = 0; vb < 8; ++vb) O[h][vb] *= alpha;
      }
      lrun[h] += ps;
#pragma unroll
      for (int s = 0; s < 2; ++s) {
        u32x4 cv;
        cv.x = pack2(pv[2 * s][0], pv[2 * s][1]);
        cv.y = pack2(pv[2 * s][2], pv[2 * s][3]);
        cv.z = pack2(pv[2 * s + 1][0], pv[2 * s + 1][1]);
        cv.w = pack2(pv[2 * s + 1][2], pv[2 * s + 1][3]);
        pf[h][s] = __builtin_bit_cast(bf16x8, cv);
      }
    }
#pragma unroll
    for (int vb = 0; vb < 8; ++vb)
#pragma unroll
      for (int s = 0; s < 2; ++s) {
        const bf16x8 vf = *reinterpret_cast<const bf16x8*>(Vs + (vb * 16 + fr) * 288 + (32 * s + 8 * fq) * 2);
        O[0][vb] = __builtin_amdgcn_mfma_f32_16x16x32_bf16(vf, pf[0][s], O[0][vb], 0, 0, 0);
        O[1][vb] = __builtin_amdgcn_mfma_f32_16x16x32_bf16(vf, pf[1][s], O[1][vb], 0, 0, 0);
      }
    __syncthreads();
  }
  float linv[2];
#pragma unroll
  for (int h = 0; h < 2; ++h) {
    float lt = lrun[h];
    lt += __shfl_xor(lt, 16);
    lt += __shfl_xor(lt, 32);
    linv[h] = 1.f / lt;
  }
  float ss = 0.f;
  float ov[8][4];
#pragma unroll
  for (int vb = 0; vb < 8; ++vb)
#pragma unroll
    for (int r = 0; r < 4; ++r) {
      float o = O[0][vb][r] * linv[0] - lam * (O[1][vb][r] * linv[1]);
      ov[vb][r] = o;
      ss += o * o;
    }
  ss += __shfl_xor(ss, 16);
  ss += __shfl_xor(ss, 32);
  float rn = rsqrtf(ss * (1.f / 128.f) + EPS) * (1.f - lam_init);
#pragma unroll
  for (int vb = 0; vb < 8; ++vb) {
    int v0 = vb * 16 + 4 * fq;
    float4 g = *reinterpret_cast<const float4*>(p.c_norm + l * 128 + v0);
    uint2 o;
    o.x = pack2(ov[vb][0] * rn * g.x, ov[vb][1] * rn * g.y);
    o.y = pack2(ov[vb][2] * rn * g.z, ov[vb][3] * rn * g.w);
    *reinterpret_cast<uint2*>(mix + (size_t)qrow * DM + 1024 + hd * 128 + v0) = o;
  }
  __syncthreads();
}

__device__ __forceinline__ int opaque(int v) { asm volatile("" : "+v"(v)); return v; }

__device__ __forceinline__ void phase_m1(const int tid512, char* smem, const Params& p, int l) {
  const int N_ATT = (l == 1) ? 256 : 288;
  constexpr int N_GLA = 4608 / 4;
  constexpr int N_RG = 4 * 36 * 8;
  {
    const int tid = opaque(tid512);
#pragma unroll 1
    for (int it = blockIdx.x; it < N_ATT; it += gridDim.x) attn_item(tid, smem, p, l, it);
  }
  const int half = tid512 >> 8;
  const int VG = 2 * (int)gridDim.x;
  {
    Ctx cx; cx.tid = opaque(tid512) & 255; cx.vb = 2 * blockIdx.x + half; cx.vg = VG; cx.lds = smem + half * 65536;
    const int wid = cx.tid >> 6, lane = cx.tid & 63;
    int b0 = cx.vb - 64; if (b0 < 0) b0 += VG;
#pragma unroll 1
    for (int it = b0; it < N_GLA; it += VG) gla_pass1(cx, p, l, it * 4 + wid, reinterpret_cast<float*>(cx.lds) + wid * 4096, lane);
  }
  __syncthreads();
  {
    Ctx cx; cx.tid = opaque(tid512) & 255; cx.vb = 2 * blockIdx.x + half; cx.vg = VG; cx.lds = smem + half * 65536;
    int b0 = cx.vb - 192; if (b0 < 0) b0 += VG;
    rg_load_w(cx, p, l, b0 & 7);
    __syncthreads();
#pragma unroll 1
    for (int it = b0; it < N_RG; it += VG) rg_d1(cx, p, l, it);
  }
}
__device__ __forceinline__ void phase_m2(const Ctx& cx, const Params& p) {
  gla_pass2(cx, p);
  rg_d2(cx, p);
}
__device__ __forceinline__ void phase_m3(const int tid512, char* smem, const Params& p, int l) {
  const int N_GLA = (l == 1) ? 512 : 576;
  constexpr int N_RG = 576 * 512 / NT;
  const int half = tid512 >> 8;
  const int VG = 2 * (int)gridDim.x;
  {
    Ctx cx; cx.tid = opaque(tid512) & 255; cx.vb = 2 * blockIdx.x + half; cx.vg = VG; cx.lds = smem + half * 65536;
    const int wid = cx.tid >> 6, lane = cx.tid & 63;
#pragma unroll 1
    for (int it = cx.vb; it < N_GLA; it += VG) gla_pass3(cx, p, l, it * 4 + wid, reinterpret_cast<float*>(cx.lds) + wid * 4096, lane);
  }
  {
    Ctx cx; cx.tid = opaque(tid512) & 255; cx.vb = 2 * blockIdx.x + half; cx.vg = VG; cx.lds = smem + half * 65536;
    int b0 = cx.vb - 64; if (b0 < 0) b0 += VG;
#pragma unroll 1
    for (int it = b0; it < N_RG; it += VG) rg_d3(cx, p, l, it * NT + cx.tid);
  }
}


#define XB_TMO      128
#define XB_XCNT(j)  (256  + 64 * (j))
#define XB_XSUB(j)  (1280 + 64 * (j))
#define XB_XGEN(j)  (2304 + 64 * (j))
#define XB_TOP      3328
#define XB_TOPGEN   3392
#define XCD_BAR_WORDS 3456
#define XB_SPIN_CAP (1u << 20)
__device__ __forceinline__ unsigned xb_ld(unsigned* p)              { return __hip_atomic_load(p, __ATOMIC_RELAXED, __HIP_MEMORY_SCOPE_AGENT); }
__device__ __forceinline__ unsigned xb_add(unsigned* p, unsigned v) { return __hip_atomic_fetch_add(p, v, __ATOMIC_RELAXED, __HIP_MEMORY_SCOPE_AGENT); }
__device__ __forceinline__ unsigned xb_xcc_id() { return (unsigned)__builtin_amdgcn_s_getreg((3 << 11) | 20) & 0xFu; }
#define XB_SPIN(cond, bar) do { unsigned _sp = 0; while (cond) { __builtin_amdgcn_s_sleep(1); \
    if ((++_sp & 255u) == 0u) { if (xb_ld(&(bar)[XB_TMO])) break; if (_sp > XB_SPIN_CAP) { atomicAdd(&(bar)[XB_TMO], 1u); break; } } } } while (0)
struct XcdBarrier { unsigned* bar; unsigned x; volatile LAS unsigned* st; };
__device__ __forceinline__ XcdBarrier xcd_barrier_post(unsigned* bar, volatile LAS unsigned* st) {
  XcdBarrier b; b.bar = bar; b.x = xb_xcc_id(); b.st = st;
  if (threadIdx.x == 0) (void)xb_add(&bar[XB_XCNT(b.x)], 1u);
  return b;
}
__device__ __forceinline__ void xcd_barrier_complete(unsigned* bar, unsigned x, unsigned& nloc, unsigned& nx) {
  const unsigned G = gridDim.x * gridDim.y * gridDim.z;
  unsigned sum, cnt, mine, sp = 0u;
  for (;;) {
    sum = 0u; cnt = 0u; mine = 0u;
#pragma unroll
    for (unsigned j = 0; j < 16; ++j) { const unsigned c = xb_ld(&bar[XB_XCNT(j)]); sum += c; cnt += (c > 0u) ? 1u : 0u; mine = (j == x) ? c : mine; }
    if (sum == G) break;
    __builtin_amdgcn_s_sleep(1);
    if ((++sp & 255u) == 0u) { if (xb_ld(&bar[XB_TMO])) break; if (sp > XB_SPIN_CAP) { atomicAdd(&bar[XB_TMO], 1u); break; } }
  }
  nloc = mine > 0u ? mine : 1u; nx = cnt > 0u ? cnt : 1u;
}
__device__ __forceinline__ void xcd_barrier(const XcdBarrier& b) {
  asm volatile("s_waitcnt vmcnt(0)" ::: "memory");
  __syncthreads();
  if (threadIdx.x == 0) {
    unsigned* bar = b.bar;
    __builtin_amdgcn_s_waitcnt(0);
    unsigned nloc = b.st[0], nx = b.st[1];
    if (nloc == 0u) { xcd_barrier_complete(bar, b.x, nloc, nx); b.st[0] = nloc; b.st[1] = nx; }
    const unsigned old = xb_add(&bar[XB_XSUB(b.x)], 1u);
    const unsigned gen = old / nloc;
    if (old + 1u == (gen + 1u) * nloc) {
      __builtin_amdgcn_fence(__ATOMIC_RELEASE, "agent");
      asm volatile("s_waitcnt vmcnt(0)" ::: "memory");
      const unsigned og = xb_add(&bar[XB_TOP], 1u);
      const unsigned tg = og / nx;
      if (og + 1u == (tg + 1u) * nx) xb_add(&bar[XB_TOPGEN], 1u);
      else XB_SPIN(xb_ld(&bar[XB_TOPGEN]) == tg, bar);
      __builtin_amdgcn_fence(__ATOMIC_ACQUIRE, "agent");
      xb_add(&bar[XB_XGEN(b.x)], 1u);
      asm volatile("s_waitcnt vmcnt(0)" ::: "memory");
    } else {
      XB_SPIN(xb_ld(&bar[XB_XGEN(b.x)]) == gen, bar);
      __builtin_amdgcn_fence(__ATOMIC_ACQUIRE, "agent");
      asm volatile("s_waitcnt vmcnt(0)" ::: "memory");
    }
  }
  __syncthreads();
}

__device__ __forceinline__ void filler(const int tid512, char* smem, const Params& p, int slot, int lo, int hi) {
  if (lo >= hi) return;
  unsigned* ctr = reinterpret_cast<unsigned*>(p.ws + OFF_BAR) + 3520 + slot * 64;
  volatile LAS unsigned* bc = (volatile LAS unsigned*)((LAS unsigned char*)smem + 131072 + 8);
  const int half = tid512 >> 8;
  Ctx cx; cx.tid = tid512 & 255; cx.vb = 0; cx.vg = 1; cx.lds = smem + half * 65536;
  for (;;) {
    __syncthreads();
    if (tid512 == 0) bc[0] = __hip_atomic_fetch_add(ctr, 2u, __ATOMIC_RELAXED, __HIP_MEMORY_SCOPE_AGENT);
    __syncthreads();
    const int j = lo + (int)bc[0];
    if (j >= hi) break;
    conv_deferred(cx, p, j + half);
  }
}

constexpr int N_PHASES = 3 + 2 * 12;

__device__ __forceinline__ void run_phase(const int tid512, const Params& p, int ph) {
  extern __shared__ __attribute__((aligned(16))) char smem[];
  Ctx cx; cx.tid = tid512 & 255; cx.vb = 2 * blockIdx.x + (tid512 >> 8); cx.vg = 2 * gridDim.x; cx.lds = smem + (tid512 >> 8) * 65536;
  const float* MOD = reinterpret_cast<const float*>(p.ws + OFF_MOD);
  bfu* Y = reinterpret_cast<bfu*>(p.ws + OFF_Y);
  bfu* U = reinterpret_cast<bfu*>(p.ws + OFF_U);
  bfu* ACT = reinterpret_cast<bfu*>(p.ws + OFF_ACT);
  bfu* MIX = reinterpret_cast<bfu*>(p.ws + OFF_MIX);
  if (ph == 0) { phase0(cx, p); return; }
  if (ph == 1) { phase_modreduce(cx, p); return; }
  int l = 0, s = -1;
  if (ph >= 3) { l = (ph - 3) / 12; s = (ph - 3) % 12; }
  const float* modl = MOD + (size_t)l * 5 * NMOD;
  const bfu* Wfin = reinterpret_cast<const bfu*>(p.ws + OFF_WFIN) + (size_t)l * 2 * 11008 * 2048;
  const bfu* Wfout = reinterpret_cast<const bfu*>(p.ws + OFF_WFOUT) + (size_t)l * 2 * 2048 * 5504;
  const bfu* Win = reinterpret_cast<const bfu*>(p.ws + OFF_WIN) + (size_t)l * 7168 * 2048;
  const bfu* Wout = reinterpret_cast<const bfu*>(p.ws + OFF_WOUT) + (size_t)l * 2048 * 2048;
  LAS unsigned char* lds = (LAS unsigned char*)smem;
  int fl_slot = 0, fl_lo = 0, fl_hi = 0;
  if (s == -1 || s == 2 || s == 8 || s == 11) {
    NormArgs a{};
    if (s == -1) {
      a.first = 1; a.y = nullptr; a.y2 = nullptr; a.rs = 0.f; a.gate = MOD; a.post = p.norm_post;
      a.pre = p.norm_pre; a.shift = MOD + 0 * DM; a.scale = MOD + 1 * DM; a.write_out = 0;
    } else {
      int k = (s == 2) ? 0 : (s == 8 ? 1 : 2);
      a.first = 0; a.y = Y; a.y2 = (k == 1) ? nullptr : Y + (size_t)NROW * DM;
      a.gate = modl + (3 * k + 2) * DM; a.post = p.norm_post + (l * 3 + k) * DM;
      a.rs = (k == 1) ? 1.f : 0.5f; a.write_out = 0;
      a.skip_ctx = (l == 1 && k >= 1) ? 1 : 0;
      if (k < 2) {
        a.pre = p.norm_pre + (l * 3 + k + 1) * DM; a.shift = modl + (3 * k + 3) * DM; a.scale = modl + (3 * k + 4) * DM;
      } else if (l == 0) {
        const float* modn = MOD + (size_t)1 * 5 * NMOD;
        a.pre = p.norm_pre + (1 * 3 + 0) * DM; a.shift = modn + 0 * DM; a.scale = modn + 1 * DM;
      } else {
        a.pre = nullptr; a.shift = nullptr; a.scale = nullptr; a.write_out = 1;
      }
    }
    norm_phase(cx, p, a);
  } else if (s == 0 || s == 9) {
    Gemm g; g.A = U; g.Bt = (s == 0) ? Wfin : Wfin + (size_t)11008 * 2048; g.M = NROW; g.N = 11008; g.lda = 2048; g.S = 1; g.nt0 = 32; g.nt1 = 32;
    g.latent_only = (l == 1 && s == 9) ? 1 : 0; if (g.latent_only) g.M = 8192;
    StaticOrder S; S.init(g, gridDim.x, blockIdx.x);
    EpiSwiglu E; E.act = ACT;
    gemm_phase(tid512, lds, g, S, E);
    if (l == 0 && s == 0) { fl_slot = 0; fl_lo = 0; fl_hi = 7360; }
    else if (l == 0 && s == 9) { fl_slot = 3; fl_lo = 19360; fl_hi = 27760; }
    else if (l == 1 && s == 0) { fl_slot = 5; fl_lo = 32060; fl_hi = 36736; }
  } else if (s == 1 || s == 7 || s == 10) {
    Gemm g; g.M = NROW; g.N = 2048;
    g.latent_only = (l == 1 && (s == 7 || s == 10)) ? 1 : 0; if (g.latent_only) g.M = 8192;
    if (s == 7) { g.A = MIX; g.Bt = Wout; g.lda = 2048; g.S = 1; g.nt0 = 32; g.nt1 = 32; }
    else { g.A = ACT; g.Bt = (s == 1) ? Wfout : Wfout + (size_t)2048 * 5504; g.lda = 5504; g.S = 2; g.nt0 = 44; g.nt1 = 42; }
    StaticOrder S; S.init(g, gridDim.x, blockIdx.x);
    EpiF32 E; E.C = Y; E.ldc = 2048; E.part_stride = (size_t)NROW * DM;
    gemm_phase(tid512, lds, g, S, E);
    if (l == 0 && s == 1) { fl_slot = 1; fl_lo = 7360; fl_hi = 11660; }
    else if (l == 0 && s == 7) { fl_slot = 2; fl_lo = 11660; fl_hi = 19360; }
    else if (l == 0 && s == 10) { fl_slot = 4; fl_lo = 27760; fl_hi = 32060; }
  } else if (s == 3) {
    Gemm g; g.A = U; g.Bt = Win; g.M = NROW; g.N = 7168; g.lda = 2048; g.S = 1; g.nt0 = 32; g.nt1 = 32; g.latent_only = 0;
    StaticOrder S; S.init(g, gridDim.x, blockIdx.x);
    EpiZin E; E.z = reinterpret_cast<float*>(p.ws + OFF_Z);
    E.qc = reinterpret_cast<bfu*>(p.ws + OFF_QC); E.kc = reinterpret_cast<bfu*>(p.ws + OFF_KC); E.vt = reinterpret_cast<bfu*>(p.ws + OFF_VT);
    E.rope = reinterpret_cast<const float*>(p.ws + OFF_ROPE);
    E.lb_logits = p.lb_logits; E.layer = l; E.zb = reinterpret_cast<bfu*>(p.ws + OFF_ZB);
    gemm_phase(tid512, lds, g, S, E);
  } else if (s == 4) {
    phase_m1(tid512, smem, p, l);
  } else if (s == 5) {
    phase_m2(cx, p);
  } else if (s == 6) {
    phase_m3(tid512, smem, p, l);
  }
  if (fl_hi > fl_lo) filler(tid512, smem, p, fl_slot, fl_lo, fl_hi);
}

__global__ void __launch_bounds__(512, 2) fwd_megakernel(Params p, int ph_lo, int ph_hi) {
  extern __shared__ __attribute__((aligned(16))) char smem[];
  cg::grid_group grid = cg::this_grid();
  volatile LAS unsigned* st = (volatile LAS unsigned*)((LAS unsigned char*)smem + 131072);
  if (threadIdx.x == 0) { st[0] = 0u; st[1] = 0u; st[2] = 0u; st[3] = 0u; }
  __syncthreads();
  XcdBarrier xb = xcd_barrier_post(reinterpret_cast<unsigned*>(p.ws + OFF_BAR), st);
#pragma unroll 1
  for (int ph = ph_lo; ph <= ph_hi; ++ph) {
    int tid512 = (int)__builtin_amdgcn_workitem_id_x();
    asm volatile("" : "+v"(tid512));
    run_phase(tid512, p, ph);
    if (ph < ph_hi) {
      if (ph == 0) grid.sync();
      else xcd_barrier(xb);
    }
  }
}

extern "C" void kernel_launch(void* const* d_in, const int* in_sizes, int n_in, void* d_out, int out_size, void* d_ws, size_t ws_size,
                              hipStream_t stream) {
  constexpr size_t kDynLds = 131072 + 16;
  static int grid_blocks = 0;
  if (!grid_blocks) {
    int dev = 0, cus = 0, per_cu = 0;
    (void)hipGetDevice(&dev);
    (void)hipDeviceGetAttribute(&cus, hipDeviceAttributeMultiprocessorCount, dev);
    (void)hipFuncSetAttribute((const void*)fwd_megakernel, hipFuncAttributeMaxDynamicSharedMemorySize, (int)kDynLds);
    (void)hipOccupancyMaxActiveBlocksPerMultiprocessor(&per_cu, fwd_megakernel, 512, kDynLds);
    if (per_cu < 1) per_cu = 1;
    per_cu = 1;
    grid_blocks = cus * per_cu;
  }
  if (ws_size < WS_NEED) fprintf(stderr, "workspace too small: %zu < %zu\n", ws_size, (size_t)WS_NEED);
  Params p{};
  const float** pp = reinterpret_cast<const float**>(&p);
  for (int i = 0; i < 24; ++i) pp[i] = (const float*)d_in[i];
  p.out = (float*)d_out;
  p.ws = (char*)d_ws;
  (void)hipMemsetAsync((char*)d_ws + OFF_BAR, 0, 16384, stream);
  int lo = 0, hi = N_PHASES - 1;
  void* args[] = {&p, &lo, &hi};
  hipError_t err = hipLaunchCooperativeKernel((const void*)fwd_megakernel, dim3(grid_blocks), dim3(512), args, kDynLds, stream);
  if (err != hipSuccess) fprintf(stderr, "cooperative launch failed: %s (grid %d)\n", hipGetErrorString(err), grid_blocks);
}
```

```cpp
#include <hip/hip_runtime.h>
#include <hip/hip_bf16.h>
#include <hip/hip_cooperative_groups.h>
#include <cstdio>
namespace cg = cooperative_groups;

typedef unsigned short bfu;
using bf16x8 = __attribute__((ext_vector_type(8))) short;
using f32x4 = __attribute__((ext_vector_type(4))) float;
using f32x2 = __attribute__((ext_vector_type(2))) float;
using u32x4 = __attribute__((ext_vector_type(4))) unsigned;
using u32x2 = __attribute__((ext_vector_type(2))) unsigned;

constexpr int DM = 2048, TPB = 2304, NROW = 9216, DFF = 5504, INW = 7168, NMOD = 18432;
constexpr int NT = 256;
constexpr float EPS = 1e-6f;

constexpr size_t SZ_WFIN = (size_t)2 * 2 * 11008 * 2048 * 2;
constexpr size_t SZ_WFOUT = (size_t)2 * 2 * 2048 * 5504 * 2;
constexpr size_t SZ_WIN = (size_t)2 * 7168 * 2048 * 2;
constexpr size_t SZ_WOUT = (size_t)2 * 2048 * 2048 * 2;
constexpr int KS_MOD = 16;
constexpr size_t SZ_MODP = (size_t)2 * KS_MOD * 5 * NMOD * 4;
constexpr size_t SZ_MOD = (size_t)2 * 5 * NMOD * 4;
constexpr size_t SZ_ROPE = (size_t)2048 * 32 * 8;
constexpr size_t SZ_H = (size_t)NROW * DM * 4;
constexpr size_t SZ_U = (size_t)NROW * DM * 2;
constexpr size_t SZ_Z = (size_t)NROW * INW * 4;
constexpr size_t SZ_ACT = (size_t)NROW * DFF * 2;
constexpr size_t SZ_QC = (size_t)NROW * 512 * 2;
constexpr size_t SZ_GU = (size_t)2 * 4 * 8 * 2 * 36 * 4096 * 4;
constexpr size_t SZ_GG = (size_t)2 * 4 * 8 * 2 * 36 * 64 * 4;
constexpr size_t SZ_OFWD = (size_t)2 * NROW * 1024 * 4;
constexpr size_t SZ_AU = (size_t)2 * NROW * 512 * 8;
constexpr size_t SZ_PH = (size_t)4 * 2 * 144 * 512 * 8;

constexpr size_t OFF_WFIN = 0;
constexpr size_t OFF_WFOUT = OFF_WFIN + SZ_WFIN;
constexpr size_t OFF_WIN = OFF_WFOUT + SZ_WFOUT;
constexpr size_t OFF_WOUT = OFF_WIN + SZ_WIN;
constexpr size_t OFF_MODP = OFF_WOUT + SZ_WOUT;
constexpr size_t OFF_MOD = OFF_MODP + SZ_MODP;
constexpr size_t OFF_ROPE = OFF_MOD + SZ_MOD;
constexpr size_t OFF_H = OFF_ROPE + SZ_ROPE;
constexpr size_t OFF_U = OFF_H + SZ_H;
constexpr size_t OFF_Z = OFF_U + SZ_U;
constexpr size_t OFF_ACT = OFF_Z;
constexpr size_t OFF_Y = OFF_Z + SZ_ACT;
constexpr size_t OFF_QC = OFF_Z + SZ_Z;
constexpr size_t OFF_KC = OFF_QC + SZ_QC;
constexpr size_t OFF_VT = OFF_KC + SZ_QC;
constexpr size_t OFF_MIX = OFF_VT + SZ_QC;
constexpr size_t OFF_GU = OFF_MIX + SZ_U;
constexpr size_t OFF_GG = OFF_GU + SZ_GU;
constexpr size_t OFF_OFWD = OFF_GG + SZ_GG;
constexpr size_t OFF_AU = OFF_OFWD + SZ_OFWD;
constexpr size_t OFF_PH = OFF_AU + SZ_AU;
constexpr size_t OFF_BAR = OFF_PH + SZ_PH;
constexpr size_t OFF_ZG = OFF_BAR + 16384;
constexpr size_t WS_NEED = OFF_ZG + (size_t)NROW * 1024 * 2;

struct Params {
  const float *x, *c, *ctx, *c_ctx, *w_ada, *b_ada, *norm_pre, *norm_post, *ffn_w_in, *ffn_w_out, *w_in, *w_out,
      *lb_logits, *a_norm, *b_norm, *c_lambda, *c_norm, *d_conv_w, *d_conv_b, *d_w_r, *d_b_r, *d_w_i, *d_b_i, *d_lambda;
  float* out;
  char* ws;
};

__device__ __forceinline__ bfu f2bf(float f) {
  unsigned u = __float_as_uint(f);
  u += 0x7fffu + ((u >> 16) & 1u);
  return (bfu)(u >> 16);
}
typedef __bf16 bf16v2_t __attribute__((ext_vector_type(2)));
__device__ __forceinline__ unsigned pack2(float a, float b) {
  bf16v2_t r = __builtin_convertvector((f32x2){a, b}, bf16v2_t);
  return __builtin_bit_cast(unsigned, r);
}
__device__ __forceinline__ float sigmoidf_(float x) { return __builtin_amdgcn_rcpf(1.f + __builtin_amdgcn_exp2f(-1.44269504088896f * x)); }
__device__ __forceinline__ float siluf_(float x) { return x * sigmoidf_(x); }
__device__ __forceinline__ float geluf_(float x) {
  float y = 0.7978845608028654f * (x + 0.044715f * x * x * x);
  float t = 1.f - 2.f / (1.f + __expf(2.f * y));
  return 0.5f * x * (1.f + t);
}
__device__ __forceinline__ float wave_sum(float v) {
#pragma unroll
  for (int o = 32; o >= 1; o >>= 1) v += __shfl_xor(v, o);
  return v;
}
__device__ __forceinline__ void wave_fence() {
  __builtin_amdgcn_fence(__ATOMIC_RELEASE, "wavefront");
  __builtin_amdgcn_wave_barrier();
  __builtin_amdgcn_fence(__ATOMIC_ACQUIRE, "wavefront");
}

struct Ctx {
  int tid;
  int vb, vg;
  char* lds;
};

#define LAS __attribute__((address_space(3)))
constexpr int BM = 256, BK = 64, HALF = 128, HTB = HALF * BK * 2, NXCD = 8, WGM = 8;
__device__ __forceinline__ int lds_byte(int r, int c) {
  const int st = (r >> 4) * 2 + (c >> 5), rr = r & 15, cc = c & 31, ob = rr * 64 + cc * 2;
  return st * 1024 + (ob ^ (((ob >> 9) & 1) << 5));
}
__device__ __forceinline__ void stage_rc(int b, int& R, int& C) {
  const int st = b / 1024, sb = b % 1024, swz = sb ^ (((sb >> 9) & 1) << 5);
  R = (st >> 1) * 16 + swz / 64;
  C = (st & 1) * 32 + (swz % 64) / 2;
}
struct Unit { int pm, pn, ks; };
struct Gemm {
  const bfu* A; const bfu* Bt;
  int M, N, lda;
  int S;
  int latent_only;
  int nt0, nt1;
};
struct StaticOrder {
  int nM, nN, per, nwg, G, c, lat;
  __device__ void init(const Gemm& g, int G_, int c_) { lat = g.latent_only; nM = g.M / BM; nN = g.N / BM; per = nM * nN; nwg = per * g.S; G = G_; c = c_; }
  __device__ bool next(int i, Unit& u) const {
    const long L = (long)i * G + c;
    if (L >= nwg) return false;
    int wgid = (int)L;
    { const int q = nwg / NXCD, r = nwg % NXCD, xcd = wgid % NXCD, off = wgid / NXCD; wgid = (xcd < r ? xcd * (q + 1) : r * (q + 1) + (xcd - r) * q) + off; }
    u.ks = wgid / per; wgid = wgid % per;
    const int nig = WGM * nN, gid = wgid / nig, fm = gid * WGM, gsz = (nM - fm) < WGM ? (nM - fm) : WGM;
    u.pm = fm + ((wgid % nig) % gsz); u.pn = (wgid % nig) / gsz;
    if (lat) u.pm = (u.pm >> 3) * 9 + 1 + (u.pm & 7);
    return true;
  }
};

struct EpiF32 {
  bfu* C; int ldc; size_t part_stride;
  __device__ __forceinline__ void operator()(const f32x4 (&acc)[2][2][4][2], const Unit& u, int wr, int wc, int fr, int fq) const {
    const int row0 = u.pm * BM + wr * 64 + fr, col0 = u.pn * BM + wc * 32 + 4 * fq;
    bfu* Cb = C + (size_t)u.ks * part_stride;
#pragma unroll
    for (int ai = 0; ai < 2; ++ai)
#pragma unroll
      for (int m = 0; m < 4; ++m) {
        bfu* rowp = Cb + (size_t)(row0 + ai * HALF + m * 16) * ldc + col0;
#pragma unroll
        for (int bj = 0; bj < 2; ++bj)
#pragma unroll
          for (int n = 0; n < 2; ++n) {
            const f32x4 v = acc[ai][bj][m][n];
            uint2 o; o.x = pack2(v[0], v[1]); o.y = pack2(v[2], v[3]);
            *reinterpret_cast<uint2*>(rowp + bj * HALF + n * 16) = o;
          }
      }
  }
};
struct EpiSwiglu {
  bfu* act;
  __device__ __forceinline__ void operator()(const f32x4 (&acc)[2][2][4][2], const Unit& u, int wr, int wc, int fr, int fq) const {
    const int row0 = u.pm * BM + wr * 64 + fr;
#pragma unroll
    for (int ai = 0; ai < 2; ++ai)
#pragma unroll
      for (int m = 0; m < 4; ++m) {
        bfu* rowp = act + (size_t)(row0 + ai * HALF + m * 16) * DFF;
#pragma unroll
        for (int bj = 0; bj < 2; ++bj) {
          const int oc = (u.pn * BM + bj * HALF + wc * 32) / 2 + 4 * fq;
          const f32x4 g = acc[ai][bj][m][0], up = acc[ai][bj][m][1];
          uint2 o;
          o.x = pack2(siluf_(g[0]) * up[0], siluf_(g[1]) * up[1]);
          o.y = pack2(siluf_(g[2]) * up[2], siluf_(g[3]) * up[3]);
          *reinterpret_cast<uint2*>(rowp + oc) = o;
        }
      }
  }
};
struct EpiZin {
  float* z; bfu *qc, *kc, *vt; const float* rope;
  bfu* zg;
  const float* lb_logits; int layer;
  __device__ __forceinline__ void operator()(const f32x4 (&acc)[2][2][4][2], const Unit& u, int wr, int wc, int fr, int fq) const {
    const int brow = u.pm * BM;
    const int bb = brow / TPB, tbase = brow % TPB;
    const bool latent = tbase >= 256;
#pragma unroll
    for (int bj = 0; bj < 2; ++bj) {
      const int cb = u.pn * BM + bj * HALF + wc * 32;
      const int sec = cb >> 9;
      const bool ropesec = (sec == 5 || sec == 6 || sec == 9 || sec == 10);
      const float sc = (sec == 6) ? 0.125f : (sec == 9 ? 0.125f * 1.44269504088896f : 1.f);
      const int c0 = ropesec ? ((cb & ~63) + 16 * ((cb >> 5) & 1) + 4 * fq) : (cb + 4 * fq);
      const int cstep = ropesec ? 32 : 16;
      float lb0[4] = {0.f, 0.f, 0.f, 0.f}, lb1[4] = {0.f, 0.f, 0.f, 0.f};
      if ((sec == 1 || sec == 2) && layer == 1) {
#pragma unroll
        for (int j = 0; j < 4; ++j) {
          const int ca = (c0 & 511) + j, cb2 = ca + 16;
          const float* lg = lb_logits + (sec - 1) * 512;
          float a0 = lg[ca], a1 = lg[1024 + ca], mx = fmaxf(a0, a1);
          float e0 = __expf(a0 - mx), e1 = __expf(a1 - mx);
          lb0[j] = e1 / (e0 + e1);
          a0 = lg[cb2]; a1 = lg[1024 + cb2]; mx = fmaxf(a0, a1);
          e0 = __expf(a0 - mx); e1 = __expf(a1 - mx);
          lb1[j] = e1 / (e0 + e1);
        }
      }
#pragma unroll
      for (int ai = 0; ai < 2; ++ai)
#pragma unroll
        for (int m = 0; m < 4; ++m) {
          const int rl = ai * HALF + wr * 64 + m * 16 + fr;
          const int row = brow + rl;
          f32x4 v0 = acc[ai][bj][m][0] * sc, v1 = acc[ai][bj][m][1] * sc;
          if (sec == 0 || sec == 4 || sec == 8) {
#pragma unroll
            for (int j = 0; j < 4; ++j) { v0[j] = siluf_(v0[j]); v1[j] = siluf_(v1[j]); }
          } else if (sec == 13) {
#pragma unroll
            for (int j = 0; j < 4; ++j) { v0[j] = geluf_(v0[j]); v1[j] = geluf_(v1[j]); }
          } else if (sec == 1 || sec == 2) {
#pragma unroll
            for (int j = 0; j < 4; ++j) {
              v0[j] = lb0[j] + (1.f - lb0[j]) * sigmoidf_(v0[j]);
              v1[j] = lb1[j] + (1.f - lb1[j]) * sigmoidf_(v1[j]);
            }
          }
          if (ropesec && latent) {
            const int tl = tbase - 256 + rl;
            const float* rp = rope + ((size_t)tl * 32 + (c0 & 31)) * 2;
            const f32x4 r0 = *reinterpret_cast<const f32x4*>(rp), r1 = *reinterpret_cast<const f32x4*>(rp + 4);
            const float cs[4] = {r0[0], r0[2], r1[0], r1[2]}, sn[4] = {r0[1], r0[3], r1[1], r1[3]};
#pragma unroll
            for (int j = 0; j < 4; ++j) {
              const float x1 = v0[j], x2 = v1[j];
              v0[j] = x1 * cs[j] - x2 * sn[j];
              v1[j] = x2 * cs[j] + x1 * sn[j];
            }
          }
          if (sec == 9 || sec == 10) {
            bfu* dst = (sec == 9 ? qc : kc) + (size_t)row * 512 + (c0 - (sec == 9 ? 4608 : 5120));
            uint2 o0, o1;
            o0.x = pack2(v0[0], v0[1]); o0.y = pack2(v0[2], v0[3]);
            o1.x = pack2(v1[0], v1[1]); o1.y = pack2(v1[2], v1[3]);
            *reinterpret_cast<uint2*>(dst) = o0;
            *reinterpret_cast<uint2*>(dst + cstep) = o1;
          } else if (sec == 11) {
            const int t = tbase + rl;
            bfu* dst = vt + ((size_t)bb * 512 + (c0 - 5632)) * TPB + t;
#pragma unroll
            for (int j = 0; j < 4; ++j) {
              dst[(size_t)j * TPB] = f2bf(v0[j]);
              dst[(size_t)(16 + j) * TPB] = f2bf(v1[j]);
            }
          } else {
            if (sec == 4 || sec == 8) {
              bfu* dst = zg + (size_t)row * 1024 + (sec == 8 ? 512 : 0) + (c0 & 511);
              *reinterpret_cast<u32x2*>(dst) = (u32x2){pack2(v0[0], v0[1]), pack2(v0[2], v0[3])};
              *reinterpret_cast<u32x2*>(dst + cstep) = (u32x2){pack2(v1[0], v1[1]), pack2(v1[2], v1[3])};
            } else {
              float* dst = z + (size_t)row * INW + c0;
              *reinterpret_cast<f32x4*>(dst) = v0;
              *reinterpret_cast<f32x4*>(dst + cstep) = v1;
            }
          }
        }
    }
  }
};

template <class Epi>
__device__ __forceinline__ void gemm_phase(const int tid, LAS unsigned char* lds, const Gemm g, const StaticOrder& S, const Epi& E) {
  const int wid = __builtin_amdgcn_readfirstlane(tid >> 6), lane = tid & 63, wr = wid >> 2, wc = wid & 3, fr = lane & 15, fq = lane >> 4;
  const int lda = g.lda;
  unsigned voffA[2];
#pragma unroll
  for (int i = 0; i < 2; ++i) { int R, C; stage_rc(tid * 16 + i * 8192, R, C); voffA[i] = (unsigned)(R * lda + C) * 2u; }
  const size_t kstep = (size_t)(BK * 2);
  const size_t hstep = (size_t)HALF * lda * 2;
  const size_t tstep = 2 * hstep;
  const unsigned ldsw = (unsigned)wid * 1024u;
  const int aoff = lds_byte(wr * 64 + fr, fq * 8), boff = lds_byte(wc * 32 + fr, fq * 8);
#define PG8_SA(b, h) (((b) * 2 + (h)) * HTB)
#define PG8_SB(b, h) ((4 + (b) * 2 + (h)) * HTB)
#define PG8_STAGE(bufoff, gbase, voff) do { _Pragma("unroll") for (int _i = 0; _i < 2; ++_i) \
        __builtin_amdgcn_global_load_lds((const unsigned*)((const char*)(gbase) + (voff)[_i]), (LAS unsigned*)(lds + (bufoff) + ldsw + _i * 8192), 16, 0, 0); } while (0)
#define PG8_LDA(dst, b, h) do { _Pragma("unroll") for (int m = 0; m < 4; ++m) _Pragma("unroll") for (int k = 0; k < 2; ++k) dst[m][k] = *(const LAS bf16x8*)(lds + PG8_SA(b, h) + aoff + m * 2048 + k * 1024); } while (0)
#define PG8_LDB(dst, b, h) do { _Pragma("unroll") for (int n = 0; n < 2; ++n) _Pragma("unroll") for (int k = 0; k < 2; ++k) dst[n][k] = *(const LAS bf16x8*)(lds + PG8_SB(b, h) + boff + n * 2048 + k * 1024); } while (0)
#define PG8_MMA(ai, bj, At, Bt) do { __builtin_amdgcn_s_setprio(1); _Pragma("unroll") for (int m = 0; m < 4; ++m) _Pragma("unroll") for (int n = 0; n < 2; ++n) _Pragma("unroll") for (int k = 0; k < 2; ++k) \
        acc[ai][bj][m][n] = __builtin_amdgcn_mfma_f32_16x16x32_bf16(Bt[n][k], At[m][k], acc[ai][bj][m][n], 0, 0, 0); __builtin_amdgcn_s_setprio(0); } while (0)
#define PG8_WAIT_V(n) asm volatile("s_waitcnt vmcnt(" #n ")" ::: "memory")
#define PG8_WAIT_L(n) asm volatile("s_waitcnt lgkmcnt(" #n ")" ::: "memory")
#define PG8_BAR __builtin_amdgcn_s_barrier()
#define PG8_SCHED __builtin_amdgcn_sched_barrier(0)
  Unit cur, nxt; int ui = 0;
  if (!S.next(0, cur)) return;
  f32x4 acc[2][2][4][2];
#pragma unroll
  for (int a = 0; a < 2; ++a)
#pragma unroll
    for (int b = 0; b < 2; ++b)
#pragma unroll
      for (int m = 0; m < 4; ++m)
#pragma unroll
        for (int n = 0; n < 2; ++n) acc[a][b][m][n] = (f32x4){0.f, 0.f, 0.f, 0.f};
  bf16x8 At[4][2], B0[2][2], B1[2][2];
  const size_t ks1 = (size_t)g.nt0 * kstep;
  const char* cA = (const char*)g.A + (size_t)cur.pm * tstep + (cur.ks ? ks1 : 0);
  const char* cB = (const char*)g.Bt + (size_t)cur.pn * tstep + (cur.ks ? ks1 : 0);
  int nt = cur.ks ? g.nt1 : g.nt0;
  PG8_STAGE(PG8_SB(0, 0), cB, voffA); PG8_STAGE(PG8_SA(0, 0), cA, voffA); PG8_STAGE(PG8_SB(0, 1), cB + hstep, voffA); PG8_STAGE(PG8_SA(0, 1), cA + hstep, voffA);
  if (wr == 1) PG8_BAR;
  PG8_WAIT_V(4); PG8_BAR;
  PG8_STAGE(PG8_SB(1, 0), cB + kstep, voffA); PG8_STAGE(PG8_SA(1, 0), cA + kstep, voffA); PG8_STAGE(PG8_SB(1, 1), cB + hstep + kstep, voffA);
  PG8_WAIT_V(6); PG8_BAR;
  for (;;) {
    const bool has_next = S.next(ui + 1, nxt);
    const char* nA = has_next ? (const char*)g.A + (size_t)nxt.pm * tstep + (nxt.ks ? ks1 : 0) : cA;
    const char* nB = has_next ? (const char*)g.Bt + (size_t)nxt.pn * tstep + (nxt.ks ? ks1 : 0) : cB;
#pragma unroll 1
    for (int t = 0; t < nt; t += 2) {
      const bool last = (t == nt - 2);
      const char* a1 = cA + (size_t)(t + 1) * kstep;
      const char* a2 = last ? nA : cA + (size_t)(t + 2) * kstep; const char* b2 = last ? nB : cB + (size_t)(t + 2) * kstep;
      const char* a3 = a2 + kstep; const char* b3 = b2 + kstep;
      PG8_LDB(B0, 0, 0); PG8_SCHED; PG8_LDA(At, 0, 0); PG8_STAGE(PG8_SA(1, 1), a1 + hstep, voffA);
      PG8_WAIT_L(8); PG8_BAR; PG8_WAIT_L(0); PG8_MMA(0, 0, At, B0); PG8_BAR; PG8_SCHED;
      PG8_LDB(B1, 0, 1); PG8_STAGE(PG8_SB(0, 0), b2, voffA);
      PG8_BAR; PG8_WAIT_L(0); PG8_MMA(0, 1, At, B1); PG8_BAR;
      PG8_LDA(At, 0, 1); PG8_STAGE(PG8_SA(0, 0), a2, voffA);
      PG8_BAR; PG8_WAIT_L(0); PG8_MMA(1, 0, At, B0); PG8_BAR; PG8_SCHED;
      PG8_STAGE(PG8_SB(0, 1), b2 + hstep, voffA);
      PG8_WAIT_V(6); PG8_BAR; PG8_MMA(1, 1, At, B1); PG8_BAR;
      PG8_LDB(B0, 1, 0); PG8_SCHED; PG8_LDA(At, 1, 0); PG8_STAGE(PG8_SA(0, 1), a2 + hstep, voffA);
      PG8_WAIT_L(8); PG8_BAR; PG8_WAIT_L(0); PG8_MMA(0, 0, At, B0); PG8_BAR; PG8_SCHED;
      PG8_LDB(B1, 1, 1); PG8_STAGE(PG8_SB(1, 0), b3, voffA);
      PG8_BAR; PG8_WAIT_L(0); PG8_MMA(0, 1, At, B1); PG8_BAR;
      PG8_LDA(At, 1, 1); PG8_STAGE(PG8_SA(1, 0), a3, voffA);
      PG8_BAR; PG8_WAIT_L(0); PG8_MMA(1, 0, At, B0); PG8_BAR; PG8_SCHED;
      PG8_STAGE(PG8_SB(1, 1), b3 + hstep, voffA);
      PG8_WAIT_V(6); PG8_BAR; PG8_MMA(1, 1, At, B1); PG8_BAR;
    }
    E(acc, cur, wr, wc, fr, fq);
    if (!has_next) break;
#pragma unroll
    for (int a = 0; a < 2; ++a)
#pragma unroll
      for (int b = 0; b < 2; ++b)
#pragma unroll
        for (int m = 0; m < 4; ++m)
#pragma unroll
          for (int n = 0; n < 2; ++n) acc[a][b][m][n] = (f32x4){0.f, 0.f, 0.f, 0.f};
    cur = nxt; cA = nA; cB = nB; ++ui;
    nt = cur.ks ? g.nt1 : g.nt0;
  }
  PG8_WAIT_V(0);
  if (wr == 0) PG8_BAR;
  PG8_BAR;
#undef PG8_SA
#undef PG8_SB
#undef PG8_STAGE
#undef PG8_LDA
#undef PG8_LDB
#undef PG8_MMA
#undef PG8_WAIT_V
#undef PG8_WAIT_L
#undef PG8_BAR
#undef PG8_SCHED
}

__device__ __forceinline__ void conv_tile(const Ctx& cx, const float* __restrict__ src, bfu* __restrict__ dst, int K, int N, int kt, int nt, int perm) {
  char* smem = cx.lds;
  float* tile = reinterpret_cast<float*>(smem);
  const int tid = cx.tid;
  const int k0 = kt * 64, n0 = nt * 64;
#pragma unroll
  for (int i = 0; i < 4; ++i) {
    int kk = (tid >> 4) + 16 * i, nn = (tid & 15) * 4;
    float4 v = *reinterpret_cast<const float4*>(src + (size_t)(k0 + kk) * N + n0 + nn);
    tile[kk * 65 + nn] = v.x; tile[kk * 65 + nn + 1] = v.y; tile[kk * 65 + nn + 2] = v.z; tile[kk * 65 + nn + 3] = v.w;
  }
  __syncthreads();
#pragma unroll
  for (int i = 0; i < 2; ++i) {
    int q = tid + 256 * i, nn = q >> 3, kc = q & 7;
    int j = n0 + nn, drow = j;
    if (perm == 1) {
      if (j < DFF) drow = (j >> 4) * 32 + (j & 15);
      else { int jj = j - DFF; drow = (jj >> 4) * 32 + 16 + (jj & 15); }
    } else if (perm == 2) {
      int sec = j >> 9;
      if (sec == 5 || sec == 6 || sec == 9 || sec == 10) {
        int d = j & 63;
        int pos = d < 16 ? d : (d < 32 ? d + 16 : (d < 48 ? d - 16 : d));
        drow = (j & ~63) + pos;
      }
    }
    uint4 o;
    o.x = pack2(tile[(kc * 8 + 0) * 65 + nn], tile[(kc * 8 + 1) * 65 + nn]);
    o.y = pack2(tile[(kc * 8 + 2) * 65 + nn], tile[(kc * 8 + 3) * 65 + nn]);
    o.z = pack2(tile[(kc * 8 + 4) * 65 + nn], tile[(kc * 8 + 5) * 65 + nn]);
    o.w = pack2(tile[(kc * 8 + 6) * 65 + nn], tile[(kc * 8 + 7) * 65 + nn]);
    *reinterpret_cast<uint4*>(dst + (size_t)drow * K + k0 + kc * 8) = o;
  }
  __syncthreads();
}

__device__ __forceinline__ void conv_item(const Ctx& cx, const Params& p, int l, int r) {
  if (r < 11008) {
    int f = r / 5504, rr = r % 5504;
    conv_tile(cx, p.ffn_w_in + (size_t)(l * 2 + f) * 2048 * 11008, reinterpret_cast<bfu*>(p.ws + OFF_WFIN) + (size_t)(l * 2 + f) * 11008 * 2048,
              2048, 11008, rr / 172, rr % 172, 1);
  } else if (r < 16512) {
    r -= 11008;
    int f = r / 2752, rr = r % 2752;
    conv_tile(cx, p.ffn_w_out + (size_t)(l * 2 + f) * 5504 * 2048, reinterpret_cast<bfu*>(p.ws + OFF_WFOUT) + (size_t)(l * 2 + f) * 2048 * 5504,
              5504, 2048, rr / 32, rr % 32, 0);
  } else if (r < 20096) {
    r -= 16512;
    conv_tile(cx, p.w_in + (size_t)l * 2048 * 7168, reinterpret_cast<bfu*>(p.ws + OFF_WIN) + (size_t)l * 7168 * 2048, 2048, 7168, r / 112, r % 112, 2);
  } else {
    r -= 20096;
    conv_tile(cx, p.w_out + (size_t)l * 2048 * 2048, reinterpret_cast<bfu*>(p.ws + OFF_WOUT) + (size_t)l * 2048 * 2048, 2048, 2048, r / 32, r % 32, 0);
  }
}

__device__ __forceinline__ void conv_deferred(const Ctx& cx, const Params& p, int j) {
  int l, r;
  if (j < 2752) { l = 0; r = 11008 + j; }
  else if (j < 6336) { l = 0; r = 16512 + (j - 2752); }
  else if (j < 7360) { l = 0; r = 20096 + (j - 6336); }
  else if (j < 12864) { l = 0; r = 5504 + (j - 7360); }
  else if (j < 15616) { l = 0; r = 13760 + (j - 12864); }
  else if (j < 21120) { l = 1; r = (j - 15616); }
  else if (j < 23872) { l = 1; r = 11008 + (j - 21120); }
  else if (j < 27456) { l = 1; r = 16512 + (j - 23872); }
  else if (j < 28480) { l = 1; r = 20096 + (j - 27456); }
  else if (j < 33984) { l = 1; r = 5504 + (j - 28480); }
  else { l = 1; r = 13760 + (j - 33984); }
  conv_item(cx, p, l, r);
}

__device__ __forceinline__ void phase0(const Ctx& cx, const Params& p) {
  char* smem = cx.lds;
  const int tid = cx.tid;
  constexpr int N_MODP = 2 * 18 * KS_MOD;
  constexpr int N_ROPE = 256;
  constexpr int N_CONV = 5504;
  unsigned* p0ctr = reinterpret_cast<unsigned*>(p.ws + OFF_BAR) + 3520 + 6 * 64;
  volatile LAS unsigned* p0bc = (volatile LAS unsigned*)((LAS unsigned char*)(smem - (cx.vb & 1) * 65536) + 131072 + 8);
  for (;;) {
    __syncthreads();
    if ((cx.vb & 1) == 0 && tid == 0) p0bc[0] = __hip_atomic_fetch_add(p0ctr, 2u, __ATOMIC_RELAXED, __HIP_MEMORY_SCOPE_AGENT);
    __syncthreads();
    const int it = (int)p0bc[0] + (cx.vb & 1);
    if (it >= N_MODP + N_ROPE + N_CONV) break;
    if (it < N_MODP) {
      int ks = it % KS_MOD, t = it / KS_MOD, cb = t % 18, l = t / 18;
      float* cs = reinterpret_cast<float*>(smem);
      constexpr int KC = DM / KS_MOD;
      for (int i = tid; i < 5 * KC; i += NT) {
        int v = i / KC, k = i % KC;
        float cv = (v < 4) ? p.c[v * DM + ks * KC + k] : p.c_ctx[ks * KC + k];
        cs[i] = siluf_(cv);
      }
      __syncthreads();
      int col = cb * 1024 + tid * 4;
      float4 acc[5];
#pragma unroll
      for (int v = 0; v < 5; ++v) acc[v] = make_float4(0.f, 0.f, 0.f, 0.f);
      const float* wp = p.w_ada + ((size_t)l * DM + ks * KC) * NMOD + col;
#pragma unroll 4
      for (int k = 0; k < KC; ++k) {
        float4 w = *reinterpret_cast<const float4*>(wp + (size_t)k * NMOD);
#pragma unroll
        for (int v = 0; v < 5; ++v) {
          float s = cs[v * KC + k];
          acc[v].x += s * w.x; acc[v].y += s * w.y; acc[v].z += s * w.z; acc[v].w += s * w.w;
        }
      }
      float* mp = reinterpret_cast<float*>(p.ws + OFF_MODP);
#pragma unroll
      for (int v = 0; v < 5; ++v) *reinterpret_cast<float4*>(mp + ((size_t)(l * KS_MOD + ks) * 5 + v) * NMOD + col) = acc[v];
      __syncthreads();
    } else if (it < N_MODP + N_ROPE) {
      int idx = (it - N_MODP) * 256 + tid;
      int tl = idx >> 5, i = idx & 31;
      float inv = powf(10000.f, -(float)(i & 15) / 16.f);
      float pos = (i < 16) ? (float)(tl >> 6) : (float)(tl & 63);
      float ang = pos * inv;
      float2 cssn = make_float2(__cosf(ang), __sinf(ang));
      reinterpret_cast<float2*>(p.ws + OFF_ROPE)[idx] = cssn;
    } else {
      int idx = it - N_MODP - N_ROPE;
      conv_item(cx, p, 0, idx);
    }
  }
}

__device__ __forceinline__ void phase_modreduce(const Ctx& cx, const Params& p) {
  const float* mp = reinterpret_cast<const float*>(p.ws + OFF_MODP);
  float* mod = reinterpret_cast<float*>(p.ws + OFF_MOD);
  for (int idx = cx.vb * NT + cx.tid; idx < 2 * 5 * NMOD; idx += cx.vg * NT) {
    int col = idx % NMOD, t = idx / NMOD, v = t % 5, l = t / 5;
    float s = p.b_ada[l * NMOD + col];
    for (int ks = 0; ks < KS_MOD; ++ks) s += mp[((size_t)(l * KS_MOD + ks) * 5 + v) * NMOD + col];
    mod[idx] = s;
  }
}

struct NormArgs {
  int first;
  const bfu* y;
  const bfu* y2;
  const float* gate;
  const float* post;
  float rs;
  const float* pre;
  const float* shift;
  const float* scale;
  int write_out;
  int skip_ctx;
};
__device__ __forceinline__ void norm_phase(const Ctx& cx, const Params& p, NormArgs a) {
  const int wid = cx.tid >> 6, lane = cx.tid & 63;
  bfu* H = reinterpret_cast<bfu*>(p.ws + OFF_H);
  bfu* U = reinterpret_cast<bfu*>(p.ws + OFF_U);
  float* PL = reinterpret_cast<float*>(cx.lds);
  const int total = a.skip_ctx ? 4 * 2048 : NROW;
  const int rows_per = (total + cx.vg - 1) / cx.vg;
  const int q0 = cx.vb * rows_per, q1 = min(q0 + rows_per, total);
  auto row_of = [&](int q) { return a.skip_ctx ? ((q >> 11) * TPB + 256 + (q & 2047)) : q; };
  int v0 = 0, v1 = 0;
  if (q0 < q1) {
    const int ra = row_of(q0), rb = row_of(q1 - 1);
    v0 = (ra % TPB) < 256 ? 4 : ra / TPB;
    v1 = (rb % TPB) < 256 ? 4 : rb / TPB;
  }
  for (int i = cx.tid; i < 512; i += NT) {
    const int c = i * 4;
    if (a.y) {
      *reinterpret_cast<float4*>(PL + c) = *reinterpret_cast<const float4*>(a.post + c);
      *reinterpret_cast<float4*>(PL + 4096 + c) = *reinterpret_cast<const float4*>(a.gate + (size_t)v0 * NMOD + c);
      if (v1 != v0) *reinterpret_cast<float4*>(PL + 4096 + 6144 + c) = *reinterpret_cast<const float4*>(a.gate + (size_t)v1 * NMOD + c);
    }
    if (a.pre) {
      *reinterpret_cast<float4*>(PL + 2048 + c) = *reinterpret_cast<const float4*>(a.pre + c);
      *reinterpret_cast<float4*>(PL + 4096 + 2048 + c) = *reinterpret_cast<const float4*>(a.shift + (size_t)v0 * NMOD + c);
      *reinterpret_cast<float4*>(PL + 4096 + 4096 + c) = *reinterpret_cast<const float4*>(a.scale + (size_t)v0 * NMOD + c);
      if (v1 != v0) {
        *reinterpret_cast<float4*>(PL + 4096 + 6144 + 2048 + c) = *reinterpret_cast<const float4*>(a.shift + (size_t)v1 * NMOD + c);
        *reinterpret_cast<float4*>(PL + 4096 + 6144 + 4096 + c) = *reinterpret_cast<const float4*>(a.scale + (size_t)v1 * NMOD + c);
      }
    }
  }
  __syncthreads();
  for (int q = q0 + wid; q < q1; q += 4) {
    const int row = row_of(q);
    int b = row / TPB, t = row % TPB;
    int v = t < 256 ? 4 : b;
    const float* PS = PL + 4096 + (v == v0 ? 0 : 6144);
    float4 h[8];
    if (a.first) {
      const float* src = t < 256 ? p.ctx + ((size_t)b * 256 + t) * DM : p.x + ((size_t)b * 2048 + (t - 256)) * DM;
#pragma unroll
      for (int i = 0; i < 8; ++i) h[i] = *reinterpret_cast<const float4*>(src + i * 256 + lane * 4);
    } else {
#pragma unroll
      for (int i = 0; i < 8; ++i) {
        uint2 hb = *reinterpret_cast<const uint2*>(H + (size_t)row * DM + i * 256 + lane * 4);
        h[i].x = __uint_as_float(hb.x << 16); h[i].y = __uint_as_float(hb.x & 0xffff0000u);
        h[i].z = __uint_as_float(hb.y << 16); h[i].w = __uint_as_float(hb.y & 0xffff0000u);
      }
    }
    if (a.y) {
      float4 y[8];
      float ss = 0.f;
#pragma unroll
      for (int i = 0; i < 8; ++i) {
        {
          uint2 yb = *reinterpret_cast<const uint2*>(a.y + (size_t)row * DM + i * 256 + lane * 4);
          y[i].x = __uint_as_float(yb.x << 16); y[i].y = __uint_as_float(yb.x & 0xffff0000u);
          y[i].z = __uint_as_float(yb.y << 16); y[i].w = __uint_as_float(yb.y & 0xffff0000u);
        }
        if (a.y2) {
          uint2 yb = *reinterpret_cast<const uint2*>(a.y2 + (size_t)row * DM + i * 256 + lane * 4);
          y[i].x += __uint_as_float(yb.x << 16); y[i].y += __uint_as_float(yb.x & 0xffff0000u);
          y[i].z += __uint_as_float(yb.y << 16); y[i].w += __uint_as_float(yb.y & 0xffff0000u);
        }
        ss += y[i].x * y[i].x + y[i].y * y[i].y + y[i].z * y[i].z + y[i].w * y[i].w;
      }
      ss = wave_sum(ss);
      float ry = rsqrtf(ss * (1.f / DM) + EPS) * a.rs;
#pragma unroll
      for (int i = 0; i < 8; ++i) {
        int c = i * 256 + lane * 4;
        float4 g = *reinterpret_cast<const float4*>(PS + c);
        float4 po = *reinterpret_cast<const float4*>(PL + c);
        h[i].x += g.x * (y[i].x * ry * po.x);
        h[i].y += g.y * (y[i].y * ry * po.y);
        h[i].z += g.z * (y[i].z * ry * po.z);
        h[i].w += g.w * (y[i].w * ry * po.w);
      }
    }
    if (a.first || a.y) {
#pragma unroll
      for (int i = 0; i < 8; ++i) {
        uint2 hb; hb.x = pack2(h[i].x, h[i].y); hb.y = pack2(h[i].z, h[i].w);
        *reinterpret_cast<uint2*>(H + (size_t)row * DM + i * 256 + lane * 4) = hb;
      }
    }
    if (a.write_out && t >= 256) {
      float* o = p.out + ((size_t)b * 2048 + (t - 256)) * DM;
#pragma unroll
      for (int i = 0; i < 8; ++i) *reinterpret_cast<float4*>(o + i * 256 + lane * 4) = h[i];
    }
    if (a.pre) {
      float ss = 0.f;
#pragma unroll
      for (int i = 0; i < 8; ++i) ss += h[i].x * h[i].x + h[i].y * h[i].y + h[i].z * h[i].z + h[i].w * h[i].w;
      ss = wave_sum(ss);
      float rh = rsqrtf(ss * (1.f / DM) + EPS);
#pragma unroll
      for (int i = 0; i < 8; ++i) {
        int c = i * 256 + lane * 4;
        float4 pr = *reinterpret_cast<const float4*>(PL + 2048 + c);
        float4 sh = *reinterpret_cast<const float4*>(PS + 2048 + c);
        float4 sc = *reinterpret_cast<const float4*>(PS + 4096 + c);
        uint2 o;
        o.x = pack2((h[i].x * rh * pr.x) * (1.f + sc.x) + sh.x, (h[i].y * rh * pr.y) * (1.f + sc.y) + sh.y);
        o.y = pack2((h[i].z * rh * pr.z) * (1.f + sc.z) + sh.z, (h[i].w * rh * pr.w) * (1.f + sc.w) + sh.w);
        *reinterpret_cast<uint2*>(U + (size_t)row * DM + c) = o;
      }
    }
  }
}

__device__ __forceinline__ float lower_bound(const Params& p, int l, int dir, int c) {
  if (l == 0) return 0.f;
  float a0 = p.lb_logits[(0 * 2 + dir) * 512 + c], a1 = p.lb_logits[(1 * 2 + dir) * 512 + c];
  float mx = fmaxf(a0, a1);
  float e0 = __expf(a0 - mx), e1 = __expf(a1 - mx);
  return e1 / (e0 + e1);
}

using bf16x4 = __attribute__((ext_vector_type(4))) short;
__device__ __forceinline__ f32x4 mfma16k(bf16x4 a, bf16x4 b, f32x4 c, int, int, int) {
  const bf16x8 a8 = (bf16x8){a[0], a[1], a[2], a[3], 0, 0, 0, 0};
  const bf16x8 b8 = (bf16x8){b[0], b[1], b[2], b[3], 0, 0, 0, 0};
  return __builtin_amdgcn_mfma_f32_16x16x32_bf16(a8, b8, c, 0, 0, 0);
}
__device__ __forceinline__ bfu f2bf_hw(float x) { return (bfu)(pack2(x, x) & 0xffffu); }

__device__ __forceinline__ void gla_pass1(const Ctx& cx, const Params& p, int l, int item, float* ldsf, int lane) {
  int n = item % 36, t = item / 36;
  int dir = t & 1; t >>= 1;
  int h = t & 7; t >>= 3;
  int b = t & 3, m = t >> 2;
  int tb = dir == 0 ? n : (n < 4 ? 3 - n : 39 - n);
  const float* z = reinterpret_cast<const float*>(p.ws + OFF_Z);
  const int rowbase = b * TPB + tb * 64;
  const int hc = h * 64 + lane;
  const int c = lane & 15, g = lane >> 4;
  const float lb = (m == 0) ? lower_bound(p, l, dir, hc) : 0.f;
  const float fconst = 1.f - exp2f(-5.f - (float)h);
  const int c0off = (m == 0) ? (dir ? 1024 : 512) : 3072;
  const int c1off = (m == 0) ? 1536 : 3584;
  char* L = reinterpret_cast<char*>(ldsf);
  bfu* KTs = reinterpret_cast<bfu*>(L + 4352);
  bfu* VTs = reinterpret_cast<bfu*>(L + 6912);
  float* gs = reinterpret_cast<float*>(L + 9472);
  f32x4 T[4][4];
#pragma unroll
  for (int db = 0; db < 4; ++db)
#pragma unroll
    for (int vb = 0; vb < 4; ++vb) T[db][vb] = (f32x4){0.f, 0.f, 0.f, 0.f};
  float gacc = 1.f;
  float r0[16], r1[16];
#pragma unroll
  for (int i = 0; i < 16; ++i) {
    int tok = dir ? 63 - i : i;
    const float* zr = z + (size_t)(rowbase + tok) * INW;
    r0[i] = zr[c0off + hc];
    r1[i] = zr[c1off + hc];
  }
#pragma unroll 1
  for (int sub = 0; sub < 4; ++sub) {
    {
      float kt[16];
      float e = 1.f;
#pragma unroll
      for (int i = 0; i < 16; ++i) {
        float f, k;
        if (m == 0) { f = r0[i]; k = 1.f - f; }
        else { f = fconst; k = r0[i]; }
        e = fmaxf(e * f, 1e-26f);
        kt[i] = k * __builtin_amdgcn_rcpf(e);
      }
      const float gdec = e;
      gacc *= gdec;
      gs[lane] = gdec;
#pragma unroll
      for (int q = 0; q < 4; ++q) {
        u32x2 kk, vv;
        kk.x = pack2(kt[4 * q] * gdec, kt[4 * q + 1] * gdec); kk.y = pack2(kt[4 * q + 2] * gdec, kt[4 * q + 3] * gdec);
        vv.x = pack2(r1[4 * q], r1[4 * q + 1]); vv.y = pack2(r1[4 * q + 2], r1[4 * q + 3]);
        *reinterpret_cast<u32x2*>(KTs + lane * 20 + 4 * q) = kk;
        *reinterpret_cast<u32x2*>(VTs + lane * 20 + 4 * q) = vv;
      }
    }
    wave_fence();
    if (sub < 3) {
#pragma unroll
      for (int i = 0; i < 16; ++i) {
        int s = (sub + 1) * 16 + i;
        int tok = dir ? 63 - s : s;
        const float* zr = z + (size_t)(rowbase + tok) * INW;
        r0[i] = zr[c0off + hc];
        r1[i] = zr[c1off + hc];
      }
    }
    {
      bf16x4 vA[4];
#pragma unroll
      for (int vb = 0; vb < 4; ++vb) vA[vb] = __builtin_bit_cast(bf16x4, *reinterpret_cast<const u32x2*>(VTs + (16 * vb + c) * 20 + 4 * g));
#pragma unroll
      for (int db = 0; db < 4; ++db) {
        const f32x4 g4 = *reinterpret_cast<const f32x4*>(gs + 16 * db + 4 * g);
        const bf16x4 ktA = __builtin_bit_cast(bf16x4, *reinterpret_cast<const u32x2*>(KTs + (16 * db + c) * 20 + 4 * g));
#pragma unroll
        for (int vb = 0; vb < 4; ++vb) T[db][vb] = mfma16k(ktA, vA[vb], T[db][vb] * g4, 0, 0, 0);
      }
    }
    wave_fence();
  }
  bfu* U = reinterpret_cast<bfu*>(p.ws + OFF_GU) + (size_t)item * 4096;
#pragma unroll
  for (int db = 0; db < 4; ++db)
#pragma unroll
    for (int vb = 0; vb < 4; ++vb) {
      const f32x4 tv = T[db][vb];
      *reinterpret_cast<u32x2*>(U + (16 * vb + c) * 64 + 16 * db + 4 * g) = (u32x2){pack2(tv[0], tv[1]), pack2(tv[2], tv[3])};
    }
  reinterpret_cast<float*>(p.ws + OFF_GG)[(size_t)item * 64 + lane] = gacc;
}

__device__ __forceinline__ void gla_pass2(const Ctx& cx, const Params& p) {
  unsigned* U = reinterpret_cast<unsigned*>(p.ws + OFF_GU);
  const float* G = reinterpret_cast<const float*>(p.ws + OFF_GG);
  for (int idx = cx.vb * NT + cx.tid; idx < 128 * 2048; idx += cx.vg * NT) {
    const int c = idx >> 11, e2 = idx & 2047, d0 = (2 * e2) & 63;
    float S0 = 0.f, S1 = 0.f;
    for (int n = 0; n < 36; ++n) {
      const size_t o = ((size_t)(c * 36 + n) << 11) + e2;
      const unsigned uu = U[o];
      const float2 gg = *reinterpret_cast<const float2*>(G + (size_t)(c * 36 + n) * 64 + d0);
      U[o] = pack2(S0, S1);
      S0 = gg.x * S0 + __uint_as_float(uu << 16);
      S1 = gg.y * S1 + __uint_as_float(uu & 0xffff0000u);
    }
  }
}

__device__ __forceinline__ void gla_pass3(const Ctx& cx, const Params& p, int l, int item, float* ldsf, int lane) {
  int tb, t;
  if (l == 1) { tb = 4 + (item & 31); t = item >> 5; } else { tb = item % 36; t = item / 36; }
  int h = t & 7; t >>= 3;
  int b = t & 3, m = t >> 2;
  const float* z = reinterpret_cast<const float*>(p.ws + OFF_Z);
  bfu* ofwd = reinterpret_cast<bfu*>(p.ws + OFF_OFWD);
  bfu* mix = reinterpret_cast<bfu*>(p.ws + OFF_MIX);
  const int rowbase = b * TPB + tb * 64;
  const int hc = h * 64 + lane;
  const int c = lane & 15, g = lane >> 4;
  const int dg = g, vg = c;
  const int ocol = m * 512 + h * 64 + vg * 4;
  const f32x4 gain4 = *reinterpret_cast<const f32x4*>((m == 0 ? p.a_norm : p.b_norm) + l * 64 + vg * 4);
  const float fconst = 1.f - exp2f(-5.f - (float)h);
  const int cqoff = (m == 0) ? 0 : 2560;
  const int cvoff = (m == 0) ? 1536 : 3584;
  const int cgoff = (m == 0) ? 2048 : 4096;
  char* L = reinterpret_cast<char*>(ldsf);
  bfu* Qs = reinterpret_cast<bfu*>(L);
  bfu* Ks = reinterpret_cast<bfu*>(L + 2176);
  bfu* KTs = reinterpret_cast<bfu*>(L + 4352);
  bfu* VTs = reinterpret_cast<bfu*>(L + 6912);
  float* gs = reinterpret_cast<float*>(L + 9472);
#pragma unroll 1
  for (int dir = 0; dir < 2; ++dir) {
    int n = dir == 0 ? tb : (tb < 4 ? 3 - tb : 39 - tb);
    int chain = ((m * 4 + b) * 8 + h) * 2 + dir;
    const bfu* Sp = reinterpret_cast<const bfu*>(p.ws + OFF_GU) + ((size_t)(chain * 36 + n) << 12);
    const float lb = (m == 0) ? lower_bound(p, l, dir, hc) : 0.f;
    const int cfoff = (m == 0) ? (dir ? 1024 : 512) : 3072;
    f32x4 T[4][4];
#pragma unroll
    for (int db = 0; db < 4; ++db)
#pragma unroll
      for (int vb = 0; vb < 4; ++vb) {
        const u32x2 sv = *reinterpret_cast<const u32x2*>(Sp + (16 * vb + c) * 64 + 16 * db + 4 * g);
        T[db][vb] = (f32x4){__uint_as_float(sv.x << 16), __uint_as_float(sv.x & 0xffff0000u), __uint_as_float(sv.y << 16), __uint_as_float(sv.y & 0xffff0000u)};
      }
    float r0[16], r1[16], r2[16];
#pragma unroll
    for (int i = 0; i < 16; ++i) {
      int tok = dir ? 63 - i : i;
      const float* zr = z + (size_t)(rowbase + tok) * INW;
      r0[i] = zr[cfoff + hc];
      r1[i] = zr[cqoff + hc];
      r2[i] = zr[cvoff + hc];
    }
#pragma unroll 1
    for (int sub = 0; sub < 4; ++sub) {
      {
        float kt[16];
        float e = 1.f;
#pragma unroll
        for (int i = 0; i < 16; ++i) {
          float f, k, q;
          if (m == 0) { f = r0[i]; k = 1.f - f; q = r1[i]; }
          else { f = fconst; k = r0[i]; q = r1[i]; }
          e = fmaxf(e * f, 1e-26f);
          const float ie = __builtin_amdgcn_rcpf(e);
          kt[i] = k * ie;
          Qs[i * 68 + lane] = f2bf_hw(q * e);
          Ks[i * 68 + lane] = f2bf_hw(kt[i]);
        }
        const float gdec = e;
        gs[lane] = gdec;
#pragma unroll
        for (int q = 0; q < 4; ++q) {
          u32x2 kk, vv;
          kk.x = pack2(kt[4 * q] * gdec, kt[4 * q + 1] * gdec); kk.y = pack2(kt[4 * q + 2] * gdec, kt[4 * q + 3] * gdec);
          vv.x = pack2(r2[4 * q], r2[4 * q + 1]); vv.y = pack2(r2[4 * q + 2], r2[4 * q + 3]);
          *reinterpret_cast<u32x2*>(KTs + lane * 20 + 4 * q) = kk;
          *reinterpret_cast<u32x2*>(VTs + lane * 20 + 4 * q) = vv;
        }
      }
      wave_fence();
      if (sub < 3) {
#pragma unroll
        for (int i = 0; i < 16; ++i) {
          int s = (sub + 1) * 16 + i;
          int tok = dir ? 63 - s : s;
          const float* zr = z + (size_t)(rowbase + tok) * INW;
          r0[i] = zr[cfoff + hc];
          r1[i] = zr[cqoff + hc];
          r2[i] = zr[cvoff + hc];
        }
      }
      {
        bf16x8 qB[2], kA[2];
#pragma unroll
        for (int ks = 0; ks < 2; ++ks) {
          const u32x2 qlo = *reinterpret_cast<const u32x2*>(Qs + c * 68 + 32 * ks + 4 * g);
          const u32x2 qhi = *reinterpret_cast<const u32x2*>(Qs + c * 68 + 32 * ks + 16 + 4 * g);
          const u32x2 klo = *reinterpret_cast<const u32x2*>(Ks + c * 68 + 32 * ks + 4 * g);
          const u32x2 khi = *reinterpret_cast<const u32x2*>(Ks + c * 68 + 32 * ks + 16 + 4 * g);
          qB[ks] = __builtin_bit_cast(bf16x8, (u32x4){qlo.x, qlo.y, qhi.x, qhi.y});
          kA[ks] = __builtin_bit_cast(bf16x8, (u32x4){klo.x, klo.y, khi.x, khi.y});
        }
        f32x4 AT = (f32x4){0.f, 0.f, 0.f, 0.f};
        AT = __builtin_amdgcn_mfma_f32_16x16x32_bf16(kA[0], qB[0], AT, 0, 0, 0);
        AT = __builtin_amdgcn_mfma_f32_16x16x32_bf16(kA[1], qB[1], AT, 0, 0, 0);
#pragma unroll
        for (int r = 0; r < 4; ++r) AT[r] = (4 * g + r <= c) ? AT[r] : 0.f;
        const bf16x4 pB = __builtin_bit_cast(bf16x4, (u32x2){pack2(AT[0], AT[1]), pack2(AT[2], AT[3])});
        bf16x4 vA[4];
#pragma unroll
        for (int vb = 0; vb < 4; ++vb) vA[vb] = __builtin_bit_cast(bf16x4, *reinterpret_cast<const u32x2*>(VTs + (16 * vb + c) * 20 + 4 * g));
        const int tokc = dir ? 63 - (sub * 16 + c) : (sub * 16 + c);
        bfu* orow = ofwd + ((size_t)dir * NROW + (size_t)(rowbase + tokc)) * 1024 + m * 512 + h * 64 + 4 * g;
#pragma unroll
        for (int vb = 0; vb < 4; ++vb) {
          f32x4 OT = (f32x4){0.f, 0.f, 0.f, 0.f};
          OT = mfma16k(vA[vb], pB, OT, 0, 0, 0);
#pragma unroll
          for (int ks = 0; ks < 2; ++ks) {
            const u32x4 sp = (u32x4){pack2(T[2 * ks][vb][0], T[2 * ks][vb][1]), pack2(T[2 * ks][vb][2], T[2 * ks][vb][3]),
                                     pack2(T[2 * ks + 1][vb][0], T[2 * ks + 1][vb][1]), pack2(T[2 * ks + 1][vb][2], T[2 * ks + 1][vb][3])};
            OT = __builtin_amdgcn_mfma_f32_16x16x32_bf16(__builtin_bit_cast(bf16x8, sp), qB[ks], OT, 0, 0, 0);
          }
          *reinterpret_cast<u32x2*>(orow + 16 * vb) = (u32x2){pack2(OT[0], OT[1]), pack2(OT[2], OT[3])};
        }
#pragma unroll
        for (int db = 0; db < 4; ++db) {
          const f32x4 g4 = *reinterpret_cast<const f32x4*>(gs + 16 * db + 4 * g);
          const bf16x4 ktA = __builtin_bit_cast(bf16x4, *reinterpret_cast<const u32x2*>(KTs + (16 * db + c) * 20 + 4 * g));
#pragma unroll
          for (int vb = 0; vb < 4; ++vb) T[db][vb] = mfma16k(ktA, vA[vb], T[db][vb] * g4, 0, 0, 0);
        }
      }
      wave_fence();
    }
  }
  asm volatile("s_waitcnt vmcnt(0)" ::: "memory");
#pragma unroll 1
  for (int i0 = 0; i0 < 16; i0 += 8) {
    f32x4 of[8], ob[8], gz[8];
#pragma unroll
    for (int i = 0; i < 8; ++i) {
      const size_t row = (size_t)(rowbase + dg + 4 * (i0 + i));
      {
        const u32x2 a2 = *reinterpret_cast<const u32x2*>(ofwd + row * 1024 + ocol);
        const u32x2 b2 = *reinterpret_cast<const u32x2*>(ofwd + ((size_t)NROW + row) * 1024 + ocol);
        of[i] = (f32x4){__uint_as_float(a2.x << 16), __uint_as_float(a2.x & 0xffff0000u), __uint_as_float(a2.y << 16), __uint_as_float(a2.y & 0xffff0000u)};
        ob[i] = (f32x4){__uint_as_float(b2.x << 16), __uint_as_float(b2.x & 0xffff0000u), __uint_as_float(b2.y << 16), __uint_as_float(b2.y & 0xffff0000u)};
      }
      {
        const u32x2 g2 = *reinterpret_cast<const u32x2*>(reinterpret_cast<const bfu*>(p.ws + OFF_ZG) + row * 1024 + m * 512 + h * 64 + vg * 4);
        gz[i] = (f32x4){__uint_as_float(g2.x << 16), __uint_as_float(g2.x & 0xffff0000u), __uint_as_float(g2.y << 16), __uint_as_float(g2.y & 0xffff0000u)};
      }
    }
#pragma unroll
    for (int i = 0; i < 8; ++i) {
      const size_t row = (size_t)(rowbase + dg + 4 * (i0 + i));
      const f32x4 o4 = of[i] + ob[i];
      float ss = o4[0] * o4[0] + o4[1] * o4[1] + o4[2] * o4[2] + o4[3] * o4[3];
      ss += __shfl_xor(ss, 1);
      ss += __shfl_xor(ss, 2);
      ss += __shfl_xor(ss, 4);
      ss += __shfl_xor(ss, 8);
      const float rn = rsqrtf(ss * (1.f / 64.f) + EPS);
      uint2 o;
      o.x = pack2(o4[0] * rn * gain4[0] * gz[i][0], o4[1] * rn * gain4[1] * gz[i][1]);
      o.y = pack2(o4[2] * rn * gain4[2] * gz[i][2], o4[3] * rn * gain4[3] * gz[i][3]);
      *reinterpret_cast<uint2*>(mix + row * DM + ocol) = o;
    }
  }
}

__device__ __forceinline__ void rg_load_w(const Ctx& cx, const Params& p, int l, int g) {
  bfu* wl = reinterpret_cast<bfu*>(cx.lds + 26624);
  const int c = cx.tid & 63, tq = cx.tid >> 6;
#pragma unroll
  for (int t = 0; t < 4; ++t) {
    const float* w = ((t & 1) ? p.d_w_i : p.d_w_r) + ((size_t)(l * 2 + (t >> 1)) * 8 + g) * 4096 + c;
#pragma unroll
    for (int ii = 0; ii < 16; ++ii) {
      const int i = tq * 16 + ii;
      wl[(t * 64 + c) * 72 + i] = f2bf_hw(w[i * 64]);
    }
  }
}

__device__ __forceinline__ void rg_d1(const Ctx& cx, const Params& p, int l, int item) {
  char* smem = cx.lds;
  float* xcf = reinterpret_cast<float*>(smem);
  bfu* xcb = reinterpret_cast<bfu*>(smem + 17408);
  const bfu* wl = reinterpret_cast<const bfu*>(smem + 26624);
  int g = item & 7, t = item >> 3;
  int tb = t % 36, b = t / 36;
  const int tid = cx.tid, c = tid & 63, tq = tid >> 6;
  const float* z = reinterpret_cast<const float*>(p.ws + OFF_Z);
  const int seg_lo = tb < 4 ? 0 : 256, seg_hi = tb < 4 ? 256 : TPB;
  {
    const int ch = g * 64 + c;
    float cw[4];
#pragma unroll
    for (int j = 0; j < 4; ++j) cw[j] = p.d_conv_w[(l * 4 + j) * 512 + ch];
    const float cb = p.d_conv_b[l * 512 + ch];
    const int tok0 = tb * 64 + tq * 16;
    float win[19];
#pragma unroll
    for (int i = 0; i < 19; ++i) {
      int tt = tok0 - 1 + i;
      win[i] = (tt >= seg_lo && tt < seg_hi) ? z[(size_t)(b * TPB + tt) * INW + 6144 + ch] : 0.f;
    }
#pragma unroll
    for (int i = 0; i < 16; ++i) {
      const float x = cb + cw[0] * win[i] + cw[1] * win[i + 1] + cw[2] * win[i + 2] + cw[3] * win[i + 3];
      xcf[(tq * 16 + i) * 68 + c] = x;
      xcb[(tq * 16 + i) * 72 + c] = f2bf_hw(x);
    }
  }
  __syncthreads();
  const int lane = tid & 63, c16 = lane & 15, g4 = lane >> 4;
  f32x4 pre[4][4];
  {
    bf16x8 aF[2];
#pragma unroll
    for (int ks = 0; ks < 2; ++ks) aF[ks] = *reinterpret_cast<const bf16x8*>(xcb + (tq * 16 + c16) * 72 + ks * 32 + g4 * 8);
#pragma unroll
    for (int ty = 0; ty < 4; ++ty)
#pragma unroll
      for (int cbk = 0; cbk < 4; ++cbk) {
        f32x4 acc = (f32x4){0.f, 0.f, 0.f, 0.f};
#pragma unroll
        for (int ks = 0; ks < 2; ++ks) {
          const bf16x8 bF = *reinterpret_cast<const bf16x8*>(wl + ((ty * 4 + cbk) * 16 + c16) * 72 + ks * 32 + g4 * 8);
          acc = __builtin_amdgcn_mfma_f32_16x16x32_bf16(aF[ks], bF, acc, 0, 0, 0);
        }
        pre[ty][cbk] = acc;
      }
  }
  unsigned* AU = reinterpret_cast<unsigned*>(p.ws + OFF_AU);
  float2* PH = reinterpret_cast<float2*>(p.ws + OFF_PH);
  const int tb16 = tb * 4 + tq;
  const int row0 = b * TPB + tb * 64 + tq * 16 + 4 * g4;
#pragma unroll
  for (int cbk = 0; cbk < 4; ++cbk) {
    const int ch = g * 64 + cbk * 16 + c16;
    float xc[4];
#pragma unroll
    for (int r = 0; r < 4; ++r) xc[r] = xcf[(tq * 16 + 4 * g4 + r) * 68 + cbk * 16 + c16];
#pragma unroll
    for (int dir = 0; dir < 2; ++dir) {
      const float br = p.d_b_r[(l * 2 + dir) * 512 + ch], bi = p.d_b_i[(l * 2 + dir) * 512 + ch];
      const float lam = p.d_lambda[(l * 2 + dir) * 512 + ch];
      const float sp = log1pf(__expf(-lam));
      float av[4], uv[4];
#pragma unroll
      for (int r = 0; r < 4; ++r) {
        const float rr = sigmoidf_(pre[dir * 2][cbk][r] + br);
        const float ig = sigmoidf_(pre[dir * 2 + 1][cbk][r] + bi);
        const float la = -8.f * rr * sp;
        av[r] = __expf(la);
        const float y = -2.f * la;
        float om;
        if (y < 0.25f) om = y * (1.f + y * (-0.5f + y * (0.16666667f + y * (-0.041666668f + y * 0.008333334f))));
        else om = -expm1f(-y);
        uv[r] = sqrtf(om) * (ig * xc[r]);
        {
          const float yl = -la;
          const float oma = (yl < 0.25f) ? yl * (1.f + yl * (-0.5f + yl * (0.16666667f + yl * (-0.041666668f + yl * 0.008333334f)))) : (1.f - av[r]);
          AU[((size_t)dir * NROW + row0 + r) * 512 + ch] = pack2(oma, uv[r]);
        }
      }
      float P4 = 1.f, H4 = 0.f;
#pragma unroll
      for (int s4 = 0; s4 < 4; ++s4) {
        const int r = dir ? 3 - s4 : s4;
        H4 = av[r] * H4 + uv[r];
        P4 *= av[r];
      }
      float P = 1.f, Hh = 0.f;
#pragma unroll
      for (int s4 = 0; s4 < 4; ++s4) {
        const int k = dir ? 3 - s4 : s4;
        const float Pk = __shfl(P4, c16 + 16 * k);
        const float Hk = __shfl(H4, c16 + 16 * k);
        Hh = Pk * Hh + Hk;
        P *= Pk;
      }
      const int n = dir == 0 ? tb16 : (tb16 < 16 ? 15 - tb16 : 159 - tb16);
      if (g4 == 0) PH[((size_t)(b * 2 + dir) * 144 + n) * 512 + ch] = make_float2(P, Hh);
    }
  }
  __syncthreads();
}

__device__ __forceinline__ void rg_d2(const Ctx& cx, const Params& p) {
  float2* PH = reinterpret_cast<float2*>(p.ws + OFF_PH);
  for (int idx = cx.vb * NT + cx.tid; idx < 4096; idx += cx.vg * NT) {
    int ch = idx & 511, bd = idx >> 9;
    float h = 0.f;
    for (int n = 0; n < 144; ++n) {
      size_t o = ((size_t)bd * 144 + n) * 512 + ch;
      float2 ph = PH[o];
      PH[o].y = h;
      h = ph.x * h + ph.y;
    }
  }
}

__device__ __forceinline__ void rg_d3(const Ctx& cx, const Params& p, int l, int idx) {
  const unsigned* AU = reinterpret_cast<const unsigned*>(p.ws + OFF_AU);
  const float2* PH = reinterpret_cast<const float2*>(p.ws + OFF_PH);
  const float* z = reinterpret_cast<const float*>(p.ws + OFF_Z);
  bfu* mix = reinterpret_cast<bfu*>(p.ws + OFF_MIX);
  int ch = idx & 511, rg = idx >> 9;
  int b = rg / 144, tb16 = rg % 144;
  if (l == 1 && tb16 < 16) return;
  int row0 = b * TPB + tb16 * 16;
  float hf[16];
  float h = PH[((size_t)(b * 2 + 0) * 144 + tb16) * 512 + ch].y;
#pragma unroll
  for (int i = 0; i < 16; ++i) {
    const unsigned au = AU[((size_t)(row0 + i)) * 512 + ch];
    h = (1.f - __uint_as_float(au << 16)) * h + __uint_as_float(au & 0xffff0000u);
    hf[i] = h;
  }
  int n = tb16 < 16 ? 15 - tb16 : 159 - tb16;
  h = PH[((size_t)(b * 2 + 1) * 144 + n) * 512 + ch].y;
#pragma unroll
  for (int s = 0; s < 16; ++s) {
    int i = 15 - s;
    const unsigned au = AU[((size_t)NROW + row0 + i) * 512 + ch];
    h = (1.f - __uint_as_float(au << 16)) * h + __uint_as_float(au & 0xffff0000u);
    float gz = z[(size_t)(row0 + i) * INW + 6656 + ch];
    mix[(size_t)(row0 + i) * DM + 1536 + ch] = f2bf(gz * (hf[i] + h));
  }
}

__device__ __forceinline__ void attn_item(const int tid, char* smem, const Params& p, int l, int item) {
  char* Ks = smem;
  char* Vs = smem + 18432;
  const int wid = tid >> 6, lane = tid & 63, fr = lane & 15, fq = lane >> 4;
  int qt, bh;
  if (item < 256) { const int x = item & 7, j = item >> 3; bh = x * 2 + (j >> 4); qt = 2 + (j & 15); }
  else { const int r = item - 256, x = r & 7, j = r >> 3; bh = x * 2 + (j >> 1); qt = j & 1; }
  const int hd = bh & 3, b = bh >> 2;
  const int nkt = qt < 2 ? 4 : 36;
  const bfu* Qc = reinterpret_cast<const bfu*>(p.ws + OFF_QC);
  const bfu* Kc = reinterpret_cast<const bfu*>(p.ws + OFF_KC);
  const bfu* Vt = reinterpret_cast<const bfu*>(p.ws + OFF_VT);
  bfu* mix = reinterpret_cast<bfu*>(p.ws + OFF_MIX);
  const float* lv = p.c_lambda + l * 256;
  float d1 = wave_sum(lv[lane] * lv[64 + lane]);
  float d2 = wave_sum(lv[128 + lane] * lv[192 + lane]);
  const float lam_init = 0.8f - 0.6f * expf(-0.3f * (float)l);
  const float lam = expf(d1) - expf(d2) + lam_init;

  const int qrow = b * TPB + qt * 128 + wid * 16 + fr;
  const bfu* qp = Qc + (size_t)qrow * 512 + hd * 128;
  bf16x8 qf[2][2];
#pragma unroll
  for (int h = 0; h < 2; ++h)
#pragma unroll
    for (int ks = 0; ks < 2; ++ks) qf[h][ks] = *reinterpret_cast<const bf16x8*>(qp + h * 64 + ks * 32 + fq * 8);
  f32x4 O[2][8];
#pragma unroll
  for (int h = 0; h < 2; ++h)
#pragma unroll
    for (int vb = 0; vb < 8; ++vb) O[h][vb] = (f32x4){0.f, 0.f, 0.f, 0.f};
  float mrun[2] = {-INFINITY, -INFINITY}, lrun[2] = {0.f, 0.f};

  const bfu* kbase = Kc + (size_t)(b * TPB) * 512 + hd * 128;
  const bfu* vbase = Vt + ((size_t)b * 512 + hd * 128) * TPB;
  const unsigned koff0 = (unsigned)((tid >> 4) * 512 + (tid & 15) * 8), koff1 = koff0 + 32u * 512u;
  const unsigned voff0 = (unsigned)((tid >> 3) * TPB + (tid & 7) * 8), voff1 = voff0 + 64u * (unsigned)TPB;
  const int kl0 = (tid >> 4) * 288 + (tid & 15) * 16;
  const int vq = tid & 7;
  const int vl0 = (tid >> 3) * 288 + ((vq >> 2) * 32 + 2 * (vq & 1) * 8 + ((vq >> 1) & 1) * 4) * 2;
  constexpr int ABUF = 55296;
  u32x4 kr0 = *reinterpret_cast<const u32x4*>(kbase + koff0), kr1 = *reinterpret_cast<const u32x4*>(kbase + koff1);
  u32x4 vr0 = *reinterpret_cast<const u32x4*>(vbase + voff0), vr1 = *reinterpret_cast<const u32x4*>(vbase + voff1);
  __syncthreads();
  *reinterpret_cast<u32x4*>(Ks + kl0) = kr0;
  *reinterpret_cast<u32x4*>(Ks + kl0 + 32 * 288) = kr1;
  *reinterpret_cast<u32x2*>(Vs + vl0) = (u32x2){vr0.x, vr0.y};
  *reinterpret_cast<u32x2*>(Vs + vl0 + 16) = (u32x2){vr0.z, vr0.w};
  *reinterpret_cast<u32x2*>(Vs + vl0 + 64 * 288) = (u32x2){vr1.x, vr1.y};
  *reinterpret_cast<u32x2*>(Vs + vl0 + 64 * 288 + 16) = (u32x2){vr1.z, vr1.w};
  if (nkt > 1) {
    const bfu* kb_ = kbase + (size_t)64 * 512;
    const bfu* vb_ = vbase + 64;
    kr0 = *reinterpret_cast<const u32x4*>(kb_ + koff0); kr1 = *reinterpret_cast<const u32x4*>(kb_ + koff1);
    vr0 = *reinterpret_cast<const u32x4*>(vb_ + voff0); vr1 = *reinterpret_cast<const u32x4*>(vb_ + voff1);
  }
  __syncthreads();
  char* const Ks0 = Ks; char* const Vs0 = Vs;
#pragma unroll 1
  for (int kt = 0; kt < nkt; ++kt) {
    if (kt + 1 < nkt) {
      char* Kd = Ks0 + ((kt + 1) & 1) * ABUF; char* Vd = Vs0 + ((kt + 1) & 1) * ABUF;
      *reinterpret_cast<u32x4*>(Kd + kl0) = kr0;
      *reinterpret_cast<u32x4*>(Kd + kl0 + 32 * 288) = kr1;
      *reinterpret_cast<u32x2*>(Vd + vl0) = (u32x2){vr0.x, vr0.y};
      *reinterpret_cast<u32x2*>(Vd + vl0 + 16) = (u32x2){vr0.z, vr0.w};
      *reinterpret_cast<u32x2*>(Vd + vl0 + 64 * 288) = (u32x2){vr1.x, vr1.y};
      *reinterpret_cast<u32x2*>(Vd + vl0 + 64 * 288 + 16) = (u32x2){vr1.z, vr1.w};
    }
    if (kt + 2 < nkt) {
      const bfu* kb_ = kbase + (size_t)(kt + 2) * 64 * 512;
      const bfu* vb_ = vbase + (kt + 2) * 64;
      kr0 = *reinterpret_cast<const u32x4*>(kb_ + koff0); kr1 = *reinterpret_cast<const u32x4*>(kb_ + koff1);
      vr0 = *reinterpret_cast<const u32x4*>(vb_ + voff0); vr1 = *reinterpret_cast<const u32x4*>(vb_ + voff1);
    }
    Ks = Ks0 + (kt & 1) * ABUF; Vs = Vs0 + (kt & 1) * ABUF;
    f32x4 S[2][4];
#pragma unroll
    for (int h = 0; h < 2; ++h)
#pragma unroll
      for (int kb = 0; kb < 4; ++kb) {
        f32x4 s = (f32x4){0.f, 0.f, 0.f, 0.f};
#pragma unroll
        for (int ks = 0; ks < 2; ++ks) {
          bf16x8 kf = *reinterpret_cast<const bf16x8*>(Ks + (kb * 16 + fr) * 288 + (h * 64 + ks * 32 + fq * 8) * 2);
          s = __builtin_amdgcn_mfma_f32_16x16x32_bf16(kf, qf[h][ks], s, 0, 0, 0);
        }
        S[h][kb] = s;
      }
    bf16x8 pf[2][2];
#pragma unroll
    for (int h = 0; h < 2; ++h) {
      float mx = -INFINITY;
#pragma unroll
      for (int kb = 0; kb < 4; ++kb)
#pragma unroll
        for (int r = 0; r < 4; ++r) mx = fmaxf(mx, S[h][kb][r]);
      mx = fmaxf(mx, __shfl_xor(mx, 16));
      mx = fmaxf(mx, __shfl_xor(mx, 32));
      const float mold = mrun[h];
      const float mnew = fmaxf(mold, mx);
      mrun[h] = mnew;
      float ps = 0.f;
      float pv[4][4];
#pragma unroll
      for (int kb = 0; kb < 4; ++kb)
#pragma unroll
        for (int r = 0; r < 4; ++r) {
          pv[kb][r] = __builtin_amdgcn_exp2f(S[h][kb][r] - mnew);
          ps += pv[kb][r];
        }
      if (__builtin_amdgcn_ballot_w64(mnew > mold) != 0ull) {
        const float alpha = __builtin_amdgcn_exp2f(mold - mnew);
        lrun[h] *= alpha;
#pragma unroll
        for (int vb = 0; vb < 8; ++vb) O[h][vb] *= alpha;
      }
      lrun[h] += ps;
#pragma unroll
      for (int s = 0; s < 2; ++s) {
        u32x4 cv;
        cv.x = pack2(pv[2 * s][0], pv[2 * s][1]);
        cv.y = pack2(pv[2 * s][2], pv[2 * s][3]);
        cv.z = pack2(pv[2 * s + 1][0], pv[2 * s + 1][1]);
        cv.w = pack2(pv[2 * s + 1][2], pv[2 * s + 1][3]);
        pf[h][s] = __builtin_bit_cast(bf16x8, cv);
      }
    }
#pragma unroll
    for (int vb = 0; vb < 8; ++vb)
#pragma unroll
      for (int s = 0; s < 2; ++s) {
        const bf16x8 vf = *reinterpret_cast<const bf16x8*>(Vs + (vb * 16 + fr) * 288 + (32 * s + 8 * fq) * 2);
        O[0][vb] = __builtin_amdgcn_mfma_f32_16x16x32_bf16(vf, pf[0][s], O[0][vb], 0, 0, 0);
        O[1][vb] = __builtin_amdgcn_mfma_f32_16x16x32_bf16(vf, pf[1][s], O[1][vb], 0, 0, 0);
      }
    __syncthreads();
  }
  float linv[2];
#pragma unroll
  for (int h = 0; h < 2; ++h) {
    float lt = lrun[h];
    lt += __shfl_xor(lt, 16);
    lt += __shfl_xor(lt, 32);
    linv[h] = 1.f / lt;
  }
  float ss = 0.f;
  float ov[8][4];
#pragma unroll
  for (int vb = 0; vb < 8; ++vb)
#pragma unroll
    for (int r = 0; r < 4; ++r) {
      float o = O[0][vb][r] * linv[0] - lam * (O[1][vb][r] * linv[1]);
      ov[vb][r] = o;
      ss += o * o;
    }
  ss += __shfl_xor(ss, 16);
  ss += __shfl_xor(ss, 32);
  float rn = rsqrtf(ss * (1.f / 128.f) + EPS) * (1.f - lam_init);
#pragma unroll
  for (int vb = 0; vb < 8; ++vb) {
    int v0 = vb * 16 + 4 * fq;
    float4 g = *reinterpret_cast<const float4*>(p.c_norm + l * 128 + v0);
    uint2 o;
    o.x = pack2(ov[vb][0] * rn * g.x, ov[vb][1] * rn * g.y);
    o.y = pack2(ov[vb][2] * rn * g.z, ov[vb][3] * rn * g.w);
    *reinterpret_cast<uint2*>(mix + (size_t)qrow * DM + 1024 + hd * 128 + v0) = o;
  }
  __syncthreads();
}

__device__ __forceinline__ int opaque(int v) { asm volatile("" : "+v"(v)); return v; }

__device__ __forceinline__ void phase_m1(const int tid512, char* smem, const Params& p, int l) {
  const int N_ATT = (l == 1) ? 256 : 288;
  constexpr int N_GLA = 4608 / 4;
  constexpr int N_RG = 4 * 36 * 8;
  {
    const int tid = opaque(tid512);
#pragma unroll 1
    for (int it = blockIdx.x; it < N_ATT; it += gridDim.x) attn_item(tid, smem, p, l, it);
  }
  const int half = tid512 >> 8;
  const int VG = 2 * (int)gridDim.x;
  {
    Ctx cx; cx.tid = opaque(tid512) & 255; cx.vb = 2 * blockIdx.x + half; cx.vg = VG; cx.lds = smem + half * 65536;
    const int wid = cx.tid >> 6, lane = cx.tid & 63;
    int b0 = cx.vb - 64; if (b0 < 0) b0 += VG;
#pragma unroll 1
    for (int it = b0; it < N_GLA; it += VG) gla_pass1(cx, p, l, it * 4 + wid, reinterpret_cast<float*>(cx.lds) + wid * 4096, lane);
  }
  __syncthreads();
  {
    Ctx cx; cx.tid = opaque(tid512) & 255; cx.vb = 2 * blockIdx.x + half; cx.vg = VG; cx.lds = smem + half * 65536;
    int b0 = cx.vb - 192; if (b0 < 0) b0 += VG;
    rg_load_w(cx, p, l, b0 & 7);
    __syncthreads();
#pragma unroll 1
    for (int it = b0; it < N_RG; it += VG) rg_d1(cx, p, l, it);
  }
}
__device__ __forceinline__ void phase_m2(const Ctx& cx, const Params& p) {
  gla_pass2(cx, p);
  rg_d2(cx, p);
}
__device__ __forceinline__ void phase_m3(const int tid512, char* smem, const Params& p, int l) {
  const int N_GLA = (l == 1) ? 512 : 576;
  constexpr int N_RG = 576 * 512 / NT;
  const int half = tid512 >> 8;
  const int VG = 2 * (int)gridDim.x;
  {
    Ctx cx; cx.tid = opaque(tid512) & 255; cx.vb = 2 * blockIdx.x + half; cx.vg = VG; cx.lds = smem + half * 65536;
    const int wid = cx.tid >> 6, lane = cx.tid & 63;
#pragma unroll 1
    for (int it = cx.vb; it < N_GLA; it += VG) gla_pass3(cx, p, l, it * 4 + wid, reinterpret_cast<float*>(cx.lds) + wid * 4096, lane);
  }
  {
    Ctx cx; cx.tid = opaque(tid512) & 255; cx.vb = 2 * blockIdx.x + half; cx.vg = VG; cx.lds = smem + half * 65536;
    int b0 = cx.vb - 64; if (b0 < 0) b0 += VG;
#pragma unroll 1
    for (int it = b0; it < N_RG; it += VG) rg_d3(cx, p, l, it * NT + cx.tid);
  }
}


#define XB_TMO      128
#define XB_XCNT(j)  (256  + 64 * (j))
#define XB_XSUB(j)  (1280 + 64 * (j))
#define XB_XGEN(j)  (2304 + 64 * (j))
#define XB_TOP      3328
#define XB_TOPGEN   3392
#define XCD_BAR_WORDS 3456
#define XB_SPIN_CAP (1u << 20)
__device__ __forceinline__ unsigned xb_ld(unsigned* p)              { return __hip_atomic_load(p, __ATOMIC_RELAXED, __HIP_MEMORY_SCOPE_AGENT); }
__device__ __forceinline__ unsigned xb_add(unsigned* p, unsigned v) { return __hip_atomic_fetch_add(p, v, __ATOMIC_RELAXED, __HIP_MEMORY_SCOPE_AGENT); }
__device__ __forceinline__ unsigned xb_xcc_id() { return (unsigned)__builtin_amdgcn_s_getreg((3 << 11) | 20) & 0xFu; }
#define XB_SPIN(cond, bar) do { unsigned _sp = 0; while (cond) { __builtin_amdgcn_s_sleep(1); \
    if ((++_sp & 255u) == 0u) { if (xb_ld(&(bar)[XB_TMO])) break; if (_sp > XB_SPIN_CAP) { atomicAdd(&(bar)[XB_TMO], 1u); break; } } } } while (0)
struct XcdBarrier { unsigned* bar; unsigned x; volatile LAS unsigned* st; };
__device__ __forceinline__ XcdBarrier xcd_barrier_post(unsigned* bar, volatile LAS unsigned* st) {
  XcdBarrier b; b.bar = bar; b.x = xb_xcc_id(); b.st = st;
  if (threadIdx.x == 0) (void)xb_add(&bar[XB_XCNT(b.x)], 1u);
  return b;
}
__device__ __forceinline__ void xcd_barrier_complete(unsigned* bar, unsigned x, unsigned& nloc, unsigned& nx) {
  const unsigned G = gridDim.x * gridDim.y * gridDim.z;
  unsigned sum, cnt, mine, sp = 0u;
  for (;;) {
    sum = 0u; cnt = 0u; mine = 0u;
#pragma unroll
    for (unsigned j = 0; j < 16; ++j) { const unsigned c = xb_ld(&bar[XB_XCNT(j)]); sum += c; cnt += (c > 0u) ? 1u : 0u; mine = (j == x) ? c : mine; }
    if (sum == G) break;
    __builtin_amdgcn_s_sleep(1);
    if ((++sp & 255u) == 0u) { if (xb_ld(&bar[XB_TMO])) break; if (sp > XB_SPIN_CAP) { atomicAdd(&bar[XB_TMO], 1u); break; } }
  }
  nloc = mine > 0u ? mine : 1u; nx = cnt > 0u ? cnt : 1u;
}
__device__ __forceinline__ void xcd_barrier(const XcdBarrier& b) {
  asm volatile("s_waitcnt vmcnt(0)" ::: "memory");
  __syncthreads();
  if (threadIdx.x == 0) {
    unsigned* bar = b.bar;
    __builtin_amdgcn_s_waitcnt(0);
    unsigned nloc = b.st[0], nx = b.st[1];
    if (nloc == 0u) { xcd_barrier_complete(bar, b.x, nloc, nx); b.st[0] = nloc; b.st[1] = nx; }
    const unsigned old = xb_add(&bar[XB_XSUB(b.x)], 1u);
    const unsigned gen = old / nloc;
    if (old + 1u == (gen + 1u) * nloc) {
      __builtin_amdgcn_fence(__ATOMIC_RELEASE, "agent");
      asm volatile("s_waitcnt vmcnt(0)" ::: "memory");
      const unsigned og = xb_add(&bar[XB_TOP], 1u);
      const unsigned tg = og / nx;
      if (og + 1u == (tg + 1u) * nx) xb_add(&bar[XB_TOPGEN], 1u);
      else XB_SPIN(xb_ld(&bar[XB_TOPGEN]) == tg, bar);
      __builtin_amdgcn_fence(__ATOMIC_ACQUIRE, "agent");
      xb_add(&bar[XB_XGEN(b.x)], 1u);
      asm volatile("s_waitcnt vmcnt(0)" ::: "memory");
    } else {
      XB_SPIN(xb_ld(&bar[XB_XGEN(b.x)]) == gen, bar);
      __builtin_amdgcn_fence(__ATOMIC_ACQUIRE, "agent");
      asm volatile("s_waitcnt vmcnt(0)" ::: "memory");
    }
  }
  __syncthreads();
}

__device__ __forceinline__ void filler(const int tid512, char* smem, const Params& p, int slot, int lo, int hi) {
  if (lo >= hi) return;
  unsigned* ctr = reinterpret_cast<unsigned*>(p.ws + OFF_BAR) + 3520 + slot * 64;
  volatile LAS unsigned* bc = (volatile LAS unsigned*)((LAS unsigned char*)smem + 131072 + 8);
  const int half = tid512 >> 8;
  Ctx cx; cx.tid = tid512 & 255; cx.vb = 0; cx.vg = 1; cx.lds = smem + half * 65536;
  for (;;) {
    __syncthreads();
    if (tid512 == 0) bc[0] = __hip_atomic_fetch_add(ctr, 2u, __ATOMIC_RELAXED, __HIP_MEMORY_SCOPE_AGENT);
    __syncthreads();
    const int j = lo + (int)bc[0];
    if (j >= hi) break;
    conv_deferred(cx, p, j + half);
  }
}

constexpr int N_PHASES = 3 + 2 * 12;

__device__ __forceinline__ void run_phase(const int tid512, const Params& p, int ph) {
  extern __shared__ __attribute__((aligned(16))) char smem[];
  Ctx cx; cx.tid = tid512 & 255; cx.vb = 2 * blockIdx.x + (tid512 >> 8); cx.vg = 2 * gridDim.x; cx.lds = smem + (tid512 >> 8) * 65536;
  const float* MOD = reinterpret_cast<const float*>(p.ws + OFF_MOD);
  bfu* Y = reinterpret_cast<bfu*>(p.ws + OFF_Y);
  bfu* U = reinterpret_cast<bfu*>(p.ws + OFF_U);
  bfu* ACT = reinterpret_cast<bfu*>(p.ws + OFF_ACT);
  bfu* MIX = reinterpret_cast<bfu*>(p.ws + OFF_MIX);
  if (ph == 0) { phase0(cx, p); return; }
  if (ph == 1) { phase_modreduce(cx, p); return; }
  int l = 0, s = -1;
  if (ph >= 3) { l = (ph - 3) / 12; s = (ph - 3) % 12; }
  const float* modl = MOD + (size_t)l * 5 * NMOD;
  const bfu* Wfin = reinterpret_cast<const bfu*>(p.ws + OFF_WFIN) + (size_t)l * 2 * 11008 * 2048;
  const bfu* Wfout = reinterpret_cast<const bfu*>(p.ws + OFF_WFOUT) + (size_t)l * 2 * 2048 * 5504;
  const bfu* Win = reinterpret_cast<const bfu*>(p.ws + OFF_WIN) + (size_t)l * 7168 * 2048;
  const bfu* Wout = reinterpret_cast<const bfu*>(p.ws + OFF_WOUT) + (size_t)l * 2048 * 2048;
  LAS unsigned char* lds = (LAS unsigned char*)smem;
  int fl_slot = 0, fl_lo = 0, fl_hi = 0;
  if (s == -1 || s == 2 || s == 8 || s == 11) {
    NormArgs a{};
    if (s == -1) {
      a.first = 1; a.y = nullptr; a.y2 = nullptr; a.rs = 0.f; a.gate = MOD; a.post = p.norm_post;
      a.pre = p.norm_pre; a.shift = MOD + 0 * DM; a.scale = MOD + 1 * DM; a.write_out = 0;
    } else {
      int k = (s == 2) ? 0 : (s == 8 ? 1 : 2);
      a.first = 0; a.y = Y; a.y2 = (k == 1) ? nullptr : Y + (size_t)NROW * DM;
      a.gate = modl + (3 * k + 2) * DM; a.post = p.norm_post + (l * 3 + k) * DM;
      a.rs = (k == 1) ? 1.f : 0.5f; a.write_out = 0;
      a.skip_ctx = (l == 1 && k >= 1) ? 1 : 0;
      if (k < 2) {
        a.pre = p.norm_pre + (l * 3 + k + 1) * DM; a.shift = modl + (3 * k + 3) * DM; a.scale = modl + (3 * k + 4) * DM;
      } else if (l == 0) {
        const float* modn = MOD + (size_t)1 * 5 * NMOD;
        a.pre = p.norm_pre + (1 * 3 + 0) * DM; a.shift = modn + 0 * DM; a.scale = modn + 1 * DM;
      } else {
        a.pre = nullptr; a.shift = nullptr; a.scale = nullptr; a.write_out = 1;
      }
    }
    norm_phase(cx, p, a);
  } else if (s == 0 || s == 9) {
    Gemm g; g.A = U; g.Bt = (s == 0) ? Wfin : Wfin + (size_t)11008 * 2048; g.M = NROW; g.N = 11008; g.lda = 2048; g.S = 1; g.nt0 = 32; g.nt1 = 32;
    g.latent_only = (l == 1 && s == 9) ? 1 : 0; if (g.latent_only) g.M = 8192;
    StaticOrder S; S.init(g, gridDim.x, blockIdx.x);
    EpiSwiglu E; E.act = ACT;
    gemm_phase(tid512, lds, g, S, E);
    if (l == 0 && s == 0) { fl_slot = 0; fl_lo = 0; fl_hi = 7360; }
    else if (l == 0 && s == 9) { fl_slot = 3; fl_lo = 19360; fl_hi = 27760; }
    else if (l == 1 && s == 0) { fl_slot = 5; fl_lo = 32060; fl_hi = 36736; }
  } else if (s == 1 || s == 7 || s == 10) {
    Gemm g; g.M = NROW; g.N = 2048;
    g.latent_only = (l == 1 && (s == 7 || s == 10)) ? 1 : 0; if (g.latent_only) g.M = 8192;
    if (s == 7) { g.A = MIX; g.Bt = Wout; g.lda = 2048; g.S = 1; g.nt0 = 32; g.nt1 = 32; }
    else { g.A = ACT; g.Bt = (s == 1) ? Wfout : Wfout + (size_t)2048 * 5504; g.lda = 5504; g.S = 2; g.nt0 = 44; g.nt1 = 42; }
    StaticOrder S; S.init(g, gridDim.x, blockIdx.x);
    EpiF32 E; E.C = Y; E.ldc = 2048; E.part_stride = (size_t)NROW * DM;
    gemm_phase(tid512, lds, g, S, E);
    if (l == 0 && s == 1) { fl_slot = 1; fl_lo = 7360; fl_hi = 11660; }
    else if (l == 0 && s == 7) { fl_slot = 2; fl_lo = 11660; fl_hi = 19360; }
    else if (l == 0 && s == 10) { fl_slot = 4; fl_lo = 27760; fl_hi = 32060; }
  } else if (s == 3) {
    Gemm g; g.A = U; g.Bt = Win; g.M = NROW; g.N = 7168; g.lda = 2048; g.S = 1; g.nt0 = 32; g.nt1 = 32; g.latent_only = 0;
    StaticOrder S; S.init(g, gridDim.x, blockIdx.x);
    EpiZin E; E.z = reinterpret_cast<float*>(p.ws + OFF_Z);
    E.qc = reinterpret_cast<bfu*>(p.ws + OFF_QC); E.kc = reinterpret_cast<bfu*>(p.ws + OFF_KC); E.vt = reinterpret_cast<bfu*>(p.ws + OFF_VT);
    E.rope = reinterpret_cast<const float*>(p.ws + OFF_ROPE);
    E.lb_logits = p.lb_logits; E.layer = l; E.zg = reinterpret_cast<bfu*>(p.ws + OFF_ZG);
    gemm_phase(tid512, lds, g, S, E);
  } else if (s == 4) {
    phase_m1(tid512, smem, p, l);
  } else if (s == 5) {
    phase_m2(cx, p);
  } else if (s == 6) {
    phase_m3(tid512, smem, p, l);
  }
  if (fl_hi > fl_lo) filler(tid512, smem, p, fl_slot, fl_lo, fl_hi);
}

__global__ void __launch_bounds__(512, 2) fwd_megakernel(Params p, int ph_lo, int ph_hi) {
  extern __shared__ __attribute__((aligned(16))) char smem[];
  cg::grid_group grid = cg::this_grid();
  volatile LAS unsigned* st = (volatile LAS unsigned*)((LAS unsigned char*)smem + 131072);
  if (threadIdx.x == 0) { st[0] = 0u; st[1] = 0u; st[2] = 0u; st[3] = 0u; }
  __syncthreads();
  XcdBarrier xb = xcd_barrier_post(reinterpret_cast<unsigned*>(p.ws + OFF_BAR), st);
#pragma unroll 1
  for (int ph = ph_lo; ph <= ph_hi; ++ph) {
    int tid512 = (int)__builtin_amdgcn_workitem_id_x();
    asm volatile("" : "+v"(tid512));
    run_phase(tid512, p, ph);
    if (ph < ph_hi) {
      if (ph == 0) grid.sync();
      else xcd_barrier(xb);
    }
  }
}

extern "C" void kernel_launch(void* const* d_in, const int* in_sizes, int n_in, void* d_out, int out_size, void* d_ws, size_t ws_size,
                              hipStream_t stream) {
  constexpr size_t kDynLds = 131072 + 16;
  static int grid_blocks = 0;
  if (!grid_blocks) {
    int dev = 0, cus = 0, per_cu = 0;
    (void)hipGetDevice(&dev);
    (void)hipDeviceGetAttribute(&cus, hipDeviceAttributeMultiprocessorCount, dev);
    (void)hipFuncSetAttribute((const void*)fwd_megakernel, hipFuncAttributeMaxDynamicSharedMemorySize, (int)kDynLds);
    (void)hipOccupancyMaxActiveBlocksPerMultiprocessor(&per_cu, fwd_megakernel, 512, kDynLds);
    if (per_cu < 1) per_cu = 1;
    per_cu = 1;
    grid_blocks = cus * per_cu;
  }
  if (ws_size < WS_NEED) fprintf(stderr, "workspace too small: %zu < %zu\n", ws_size, (size_t)WS_NEED);
  Params p{};
  const float** pp = reinterpret_cast<const float**>(&p);
  for (int i = 0; i < 24; ++i) pp[i] = (const float*)d_in[i];
  p.out = (float*)d_out;
  p.ws = (char*)d_ws;
  (void)hipMemsetAsync((char*)d_ws + OFF_BAR, 0, 16384, stream);
  int lo = 0, hi = N_PHASES - 1;
  void* args[] = {&p, &lo, &hi};
  hipError_t err = hipLaunchCooperativeKernel((const void*)fwd_megakernel, dim3(grid_blocks), dim3(512), args, kDynLds, stream);
  if (err != hipSuccess) fprintf(stderr, "cooperative launch failed: %s (grid %d)\n", hipGetErrorString(err), grid_blocks);
}
```

```cpp
#include <hip/hip_runtime.h>
#include <hip/hip_bf16.h>
#include <hip/hip_cooperative_groups.h>
#include <cstdio>
namespace cg = cooperative_groups;

typedef unsigned short bfu;
using bf16x8 = __attribute__((ext_vector_type(8))) short;
using f32x4 = __attribute__((ext_vector_type(4))) float;
using f32x2 = __attribute__((ext_vector_type(2))) float;
using u32x4 = __attribute__((ext_vector_type(4))) unsigned;

constexpr int DM = 2048, TPB = 2304, NROW = 9216, DFF = 5504, INW = 7168, NMOD = 18432;
constexpr int NT = 256;
constexpr float EPS = 1e-6f;

constexpr size_t SZ_WFIN = (size_t)2 * 2 * 11008 * 2048 * 2;
constexpr size_t SZ_WFOUT = (size_t)2 * 2 * 2048 * 5504 * 2;
constexpr size_t SZ_WIN = (size_t)2 * 7168 * 2048 * 2;
constexpr size_t SZ_WOUT = (size_t)2 * 2048 * 2048 * 2;
constexpr int KS_MOD = 16;
constexpr size_t SZ_MODP = (size_t)2 * KS_MOD * 5 * NMOD * 4;
constexpr size_t SZ_MOD = (size_t)2 * 5 * NMOD * 4;
constexpr size_t SZ_ROPE = (size_t)2048 * 32 * 8;
constexpr size_t SZ_H = (size_t)NROW * DM * 4;
constexpr size_t SZ_U = (size_t)NROW * DM * 2;
constexpr size_t SZ_Z = (size_t)NROW * INW * 4;
constexpr size_t SZ_ACT = (size_t)NROW * DFF * 2;
constexpr size_t SZ_QC = (size_t)NROW * 512 * 2;
constexpr size_t SZ_GU = (size_t)2 * 4 * 8 * 2 * 36 * 4096 * 4;
constexpr size_t SZ_GG = (size_t)2 * 4 * 8 * 2 * 36 * 64 * 4;
constexpr size_t SZ_OFWD = (size_t)2 * NROW * 1024 * 4;
constexpr size_t SZ_AU = (size_t)2 * NROW * 512 * 8;
constexpr size_t SZ_PH = (size_t)4 * 2 * 144 * 512 * 8;

constexpr size_t OFF_WFIN = 0;
constexpr size_t OFF_WFOUT = OFF_WFIN + SZ_WFIN;
constexpr size_t OFF_WIN = OFF_WFOUT + SZ_WFOUT;
constexpr size_t OFF_WOUT = OFF_WIN + SZ_WIN;
constexpr size_t OFF_MODP = OFF_WOUT + SZ_WOUT;
constexpr size_t OFF_MOD = OFF_MODP + SZ_MODP;
constexpr size_t OFF_ROPE = OFF_MOD + SZ_MOD;
constexpr size_t OFF_H = OFF_ROPE + SZ_ROPE;
constexpr size_t OFF_U = OFF_H + SZ_H;
constexpr size_t OFF_Z = OFF_U + SZ_U;
constexpr size_t OFF_ACT = OFF_Z;
constexpr size_t OFF_Y = OFF_Z + SZ_ACT;
constexpr size_t OFF_QC = OFF_Z + SZ_Z;
constexpr size_t OFF_KC = OFF_QC + SZ_QC;
constexpr size_t OFF_VT = OFF_KC + SZ_QC;
constexpr size_t OFF_MIX = OFF_VT + SZ_QC;
constexpr size_t OFF_GU = OFF_MIX + SZ_U;
constexpr size_t OFF_GG = OFF_GU + SZ_GU;
constexpr size_t OFF_OFWD = OFF_GG + SZ_GG;
constexpr size_t OFF_AU = OFF_OFWD + SZ_OFWD;
constexpr size_t OFF_PH = OFF_AU + SZ_AU;
constexpr size_t OFF_BAR = OFF_PH + SZ_PH;
constexpr size_t WS_NEED = OFF_BAR + 16384;

struct Params {
  const float *x, *c, *ctx, *c_ctx, *w_ada, *b_ada, *norm_pre, *norm_post, *ffn_w_in, *ffn_w_out, *w_in, *w_out,
      *lb_logits, *a_norm, *b_norm, *c_lambda, *c_norm, *d_conv_w, *d_conv_b, *d_w_r, *d_b_r, *d_w_i, *d_b_i, *d_lambda;
  float* out;
  char* ws;
};

__device__ __forceinline__ bfu f2bf(float f) {
  unsigned u = __float_as_uint(f);
  u += 0x7fffu + ((u >> 16) & 1u);
  return (bfu)(u >> 16);
}
typedef __bf16 bf16v2_t __attribute__((ext_vector_type(2)));
__device__ __forceinline__ unsigned pack2(float a, float b) {
  bf16v2_t r = __builtin_convertvector((f32x2){a, b}, bf16v2_t);
  return __builtin_bit_cast(unsigned, r);
}
__device__ __forceinline__ float sigmoidf_(float x) { return __builtin_amdgcn_rcpf(1.f + __builtin_amdgcn_exp2f(-1.44269504088896f * x)); }
__device__ __forceinline__ float siluf_(float x) { return x * sigmoidf_(x); }
__device__ __forceinline__ float geluf_(float x) {
  float y = 0.7978845608028654f * (x + 0.044715f * x * x * x);
  float t = 1.f - 2.f / (1.f + __expf(2.f * y));
  return 0.5f * x * (1.f + t);
}
__device__ __forceinline__ float wave_sum(float v) {
#pragma unroll
  for (int o = 32; o >= 1; o >>= 1) v += __shfl_xor(v, o);
  return v;
}
__device__ __forceinline__ void wave_fence() {
  __builtin_amdgcn_fence(__ATOMIC_RELEASE, "wavefront");
  __builtin_amdgcn_wave_barrier();
  __builtin_amdgcn_fence(__ATOMIC_ACQUIRE, "wavefront");
}

struct Ctx {
  int tid;
  int vb, vg;
  char* lds;
};

#define LAS __attribute__((address_space(3)))
constexpr int BM = 256, BK = 64, HALF = 128, HTB = HALF * BK * 2, NXCD = 8, WGM = 8;
__device__ __forceinline__ int lds_byte(int r, int c) {
  const int st = (r >> 4) * 2 + (c >> 5), rr = r & 15, cc = c & 31, ob = rr * 64 + cc * 2;
  return st * 1024 + (ob ^ (((ob >> 9) & 1) << 5));
}
__device__ __forceinline__ void stage_rc(int b, int& R, int& C) {
  const int st = b / 1024, sb = b % 1024, swz = sb ^ (((sb >> 9) & 1) << 5);
  R = (st >> 1) * 16 + swz / 64;
  C = (st & 1) * 32 + (swz % 64) / 2;
}
struct Unit { int pm, pn, ks; };
struct Gemm {
  const bfu* A; const bfu* Bt;
  int M, N, lda;
  int S;
  int latent_only;
  int nt0, nt1;
};
struct StaticOrder {
  int nM, nN, per, nwg, G, c, lat;
  __device__ void init(const Gemm& g, int G_, int c_) { lat = g.latent_only; nM = g.M / BM; nN = g.N / BM; per = nM * nN; nwg = per * g.S; G = G_; c = c_; }
  __device__ bool next(int i, Unit& u) const {
    const long L = (long)i * G + c;
    if (L >= nwg) return false;
    int wgid = (int)L;
    { const int q = nwg / NXCD, r = nwg % NXCD, xcd = wgid % NXCD, off = wgid / NXCD; wgid = (xcd < r ? xcd * (q + 1) : r * (q + 1) + (xcd - r) * q) + off; }
    u.ks = wgid / per; wgid = wgid % per;
    const int nig = WGM * nN, gid = wgid / nig, fm = gid * WGM, gsz = (nM - fm) < WGM ? (nM - fm) : WGM;
    u.pm = fm + ((wgid % nig) % gsz); u.pn = (wgid % nig) / gsz;
    if (lat) u.pm = (u.pm >> 3) * 9 + 1 + (u.pm & 7);
    return true;
  }
};

struct EpiF32 {
  bfu* C; int ldc; size_t part_stride;
  __device__ __forceinline__ void operator()(const f32x4 (&acc)[2][2][4][2], const Unit& u, int wr, int wc, int fr, int fq) const {
    const int row0 = u.pm * BM + wr * 64 + fr, col0 = u.pn * BM + wc * 32 + 4 * fq;
    bfu* Cb = C + (size_t)u.ks * part_stride;
#pragma unroll
    for (int ai = 0; ai < 2; ++ai)
#pragma unroll
      for (int m = 0; m < 4; ++m) {
        bfu* rowp = Cb + (size_t)(row0 + ai * HALF + m * 16) * ldc + col0;
#pragma unroll
        for (int bj = 0; bj < 2; ++bj)
#pragma unroll
          for (int n = 0; n < 2; ++n) {
            const f32x4 v = acc[ai][bj][m][n];
            uint2 o; o.x = pack2(v[0], v[1]); o.y = pack2(v[2], v[3]);
            *reinterpret_cast<uint2*>(rowp + bj * HALF + n * 16) = o;
          }
      }
  }
};
struct EpiSwiglu {
  bfu* act;
  __device__ __forceinline__ void operator()(const f32x4 (&acc)[2][2][4][2], const Unit& u, int wr, int wc, int fr, int fq) const {
    const int row0 = u.pm * BM + wr * 64 + fr;
#pragma unroll
    for (int ai = 0; ai < 2; ++ai)
#pragma unroll
      for (int m = 0; m < 4; ++m) {
        bfu* rowp = act + (size_t)(row0 + ai * HALF + m * 16) * DFF;
#pragma unroll
        for (int bj = 0; bj < 2; ++bj) {
          const int oc = (u.pn * BM + bj * HALF + wc * 32) / 2 + 4 * fq;
          const f32x4 g = acc[ai][bj][m][0], up = acc[ai][bj][m][1];
          uint2 o;
          o.x = pack2(siluf_(g[0]) * up[0], siluf_(g[1]) * up[1]);
          o.y = pack2(siluf_(g[2]) * up[2], siluf_(g[3]) * up[3]);
          *reinterpret_cast<uint2*>(rowp + oc) = o;
        }
      }
  }
};
struct EpiZin {
  float* z; bfu *qc, *kc, *vt; const float* rope;
  const float* lb_logits; int layer;
  __device__ __forceinline__ void operator()(const f32x4 (&acc)[2][2][4][2], const Unit& u, int wr, int wc, int fr, int fq) const {
    const int brow = u.pm * BM;
    const int bb = brow / TPB, tbase = brow % TPB;
    const bool latent = tbase >= 256;
#pragma unroll
    for (int bj = 0; bj < 2; ++bj) {
      const int cb = u.pn * BM + bj * HALF + wc * 32;
      const int sec = cb >> 9;
      const bool ropesec = (sec == 5 || sec == 6 || sec == 9 || sec == 10);
      const float sc = (sec == 6) ? 0.125f : (sec == 9 ? 0.125f * 1.44269504088896f : 1.f);
      const int c0 = ropesec ? ((cb & ~63) + 16 * ((cb >> 5) & 1) + 4 * fq) : (cb + 4 * fq);
      const int cstep = ropesec ? 32 : 16;
      float lb0[4] = {0.f, 0.f, 0.f, 0.f}, lb1[4] = {0.f, 0.f, 0.f, 0.f};
      if ((sec == 1 || sec == 2) && layer == 1) {
#pragma unroll
        for (int j = 0; j < 4; ++j) {
          const int ca = (c0 & 511) + j, cb2 = ca + 16;
          const float* lg = lb_logits + (sec - 1) * 512;
          float a0 = lg[ca], a1 = lg[1024 + ca], mx = fmaxf(a0, a1);
          float e0 = __expf(a0 - mx), e1 = __expf(a1 - mx);
          lb0[j] = e1 / (e0 + e1);
          a0 = lg[cb2]; a1 = lg[1024 + cb2]; mx = fmaxf(a0, a1);
          e0 = __expf(a0 - mx); e1 = __expf(a1 - mx);
          lb1[j] = e1 / (e0 + e1);
        }
      }
#pragma unroll
      for (int ai = 0; ai < 2; ++ai)
#pragma unroll
        for (int m = 0; m < 4; ++m) {
          const int rl = ai * HALF + wr * 64 + m * 16 + fr;
          const int row = brow + rl;
          f32x4 v0 = acc[ai][bj][m][0] * sc, v1 = acc[ai][bj][m][1] * sc;
          if (sec == 0 || sec == 4 || sec == 8) {
#pragma unroll
            for (int j = 0; j < 4; ++j) { v0[j] = siluf_(v0[j]); v1[j] = siluf_(v1[j]); }
          } else if (sec == 13) {
#pragma unroll
            for (int j = 0; j < 4; ++j) { v0[j] = geluf_(v0[j]); v1[j] = geluf_(v1[j]); }
          } else if (sec == 1 || sec == 2) {
#pragma unroll
            for (int j = 0; j < 4; ++j) {
              v0[j] = lb0[j] + (1.f - lb0[j]) * sigmoidf_(v0[j]);
              v1[j] = lb1[j] + (1.f - lb1[j]) * sigmoidf_(v1[j]);
            }
          }
          if (ropesec && latent) {
            const int tl = tbase - 256 + rl;
            const float* rp = rope + ((size_t)tl * 32 + (c0 & 31)) * 2;
            const f32x4 r0 = *reinterpret_cast<const f32x4*>(rp), r1 = *reinterpret_cast<const f32x4*>(rp + 4);
            const float cs[4] = {r0[0], r0[2], r1[0], r1[2]}, sn[4] = {r0[1], r0[3], r1[1], r1[3]};
#pragma unroll
            for (int j = 0; j < 4; ++j) {
              const float x1 = v0[j], x2 = v1[j];
              v0[j] = x1 * cs[j] - x2 * sn[j];
              v1[j] = x2 * cs[j] + x1 * sn[j];
            }
          }
          if (sec == 9 || sec == 10) {
            bfu* dst = (sec == 9 ? qc : kc) + (size_t)row * 512 + (c0 - (sec == 9 ? 4608 : 5120));
            uint2 o0, o1;
            o0.x = pack2(v0[0], v0[1]); o0.y = pack2(v0[2], v0[3]);
            o1.x = pack2(v1[0], v1[1]); o1.y = pack2(v1[2], v1[3]);
            *reinterpret_cast<uint2*>(dst) = o0;
            *reinterpret_cast<uint2*>(dst + cstep) = o1;
          } else if (sec == 11) {
            const int t = tbase + rl;
            bfu* dst = vt + ((size_t)bb * 512 + (c0 - 5632)) * TPB + t;
#pragma unroll
            for (int j = 0; j < 4; ++j) {
              dst[(size_t)j * TPB] = f2bf(v0[j]);
              dst[(size_t)(16 + j) * TPB] = f2bf(v1[j]);
            }
          } else {
            float* dst = z + (size_t)row * INW + c0;
            *reinterpret_cast<f32x4*>(dst) = v0;
            *reinterpret_cast<f32x4*>(dst + cstep) = v1;
          }
        }
    }
  }
};

template <class Epi>
__device__ __forceinline__ void gemm_phase(const int tid, LAS unsigned char* lds, const Gemm g, const StaticOrder& S, const Epi& E) {
  const int wid = __builtin_amdgcn_readfirstlane(tid >> 6), lane = tid & 63, wr = wid >> 2, wc = wid & 3, fr = lane & 15, fq = lane >> 4;
  const int lda = g.lda;
  unsigned voffA[2];
#pragma unroll
  for (int i = 0; i < 2; ++i) { int R, C; stage_rc(tid * 16 + i * 8192, R, C); voffA[i] = (unsigned)(R * lda + C) * 2u; }
  const size_t kstep = (size_t)(BK * 2);
  const size_t hstep = (size_t)HALF * lda * 2;
  const size_t tstep = 2 * hstep;
  const unsigned ldsw = (unsigned)wid * 1024u;
  const int aoff = lds_byte(wr * 64 + fr, fq * 8), boff = lds_byte(wc * 32 + fr, fq * 8);
#define PG8_SA(b, h) (((b) * 2 + (h)) * HTB)
#define PG8_SB(b, h) ((4 + (b) * 2 + (h)) * HTB)
#define PG8_STAGE(bufoff, gbase, voff) do { _Pragma("unroll") for (int _i = 0; _i < 2; ++_i) \
        __builtin_amdgcn_global_load_lds((const unsigned*)((const char*)(gbase) + (voff)[_i]), (LAS unsigned*)(lds + (bufoff) + ldsw + _i * 8192), 16, 0, 0); } while (0)
#define PG8_LDA(dst, b, h) do { _Pragma("unroll") for (int m = 0; m < 4; ++m) _Pragma("unroll") for (int k = 0; k < 2; ++k) dst[m][k] = *(const LAS bf16x8*)(lds + PG8_SA(b, h) + aoff + m * 2048 + k * 1024); } while (0)
#define PG8_LDB(dst, b, h) do { _Pragma("unroll") for (int n = 0; n < 2; ++n) _Pragma("unroll") for (int k = 0; k < 2; ++k) dst[n][k] = *(const LAS bf16x8*)(lds + PG8_SB(b, h) + boff + n * 2048 + k * 1024); } while (0)
#define PG8_MMA(ai, bj, At, Bt) do { __builtin_amdgcn_s_setprio(1); _Pragma("unroll") for (int m = 0; m < 4; ++m) _Pragma("unroll") for (int n = 0; n < 2; ++n) _Pragma("unroll") for (int k = 0; k < 2; ++k) \
        acc[ai][bj][m][n] = __builtin_amdgcn_mfma_f32_16x16x32_bf16(Bt[n][k], At[m][k], acc[ai][bj][m][n], 0, 0, 0); __builtin_amdgcn_s_setprio(0); } while (0)
#define PG8_WAIT_V(n) asm volatile("s_waitcnt vmcnt(" #n ")" ::: "memory")
#define PG8_WAIT_L(n) asm volatile("s_waitcnt lgkmcnt(" #n ")" ::: "memory")
#define PG8_BAR __builtin_amdgcn_s_barrier()
#define PG8_SCHED __builtin_amdgcn_sched_barrier(0)
  Unit cur, nxt; int ui = 0;
  if (!S.next(0, cur)) return;
  f32x4 acc[2][2][4][2];
#pragma unroll
  for (int a = 0; a < 2; ++a)
#pragma unroll
    for (int b = 0; b < 2; ++b)
#pragma unroll
      for (int m = 0; m < 4; ++m)
#pragma unroll
        for (int n = 0; n < 2; ++n) acc[a][b][m][n] = (f32x4){0.f, 0.f, 0.f, 0.f};
  bf16x8 At[4][2], B0[2][2], B1[2][2];
  const size_t ks1 = (size_t)g.nt0 * kstep;
  const char* cA = (const char*)g.A + (size_t)cur.pm * tstep + (cur.ks ? ks1 : 0);
  const char* cB = (const char*)g.Bt + (size_t)cur.pn * tstep + (cur.ks ? ks1 : 0);
  int nt = cur.ks ? g.nt1 : g.nt0;
  PG8_STAGE(PG8_SB(0, 0), cB, voffA); PG8_STAGE(PG8_SA(0, 0), cA, voffA); PG8_STAGE(PG8_SB(0, 1), cB + hstep, voffA); PG8_STAGE(PG8_SA(0, 1), cA + hstep, voffA);
  if (wr == 1) PG8_BAR;
  PG8_WAIT_V(4); PG8_BAR;
  PG8_STAGE(PG8_SB(1, 0), cB + kstep, voffA); PG8_STAGE(PG8_SA(1, 0), cA + kstep, voffA); PG8_STAGE(PG8_SB(1, 1), cB + hstep + kstep, voffA);
  PG8_WAIT_V(6); PG8_BAR;
  for (;;) {
    const bool has_next = S.next(ui + 1, nxt);
    const char* nA = has_next ? (const char*)g.A + (size_t)nxt.pm * tstep + (nxt.ks ? ks1 : 0) : cA;
    const char* nB = has_next ? (const char*)g.Bt + (size_t)nxt.pn * tstep + (nxt.ks ? ks1 : 0) : cB;
#pragma unroll 1
    for (int t = 0; t < nt; t += 2) {
      const bool last = (t == nt - 2);
      const char* a1 = cA + (size_t)(t + 1) * kstep;
      const char* a2 = last ? nA : cA + (size_t)(t + 2) * kstep; const char* b2 = last ? nB : cB + (size_t)(t + 2) * kstep;
      const char* a3 = a2 + kstep; const char* b3 = b2 + kstep;
      PG8_LDB(B0, 0, 0); PG8_SCHED; PG8_LDA(At, 0, 0); PG8_STAGE(PG8_SA(1, 1), a1 + hstep, voffA);
      PG8_WAIT_L(8); PG8_BAR; PG8_WAIT_L(0); PG8_MMA(0, 0, At, B0); PG8_BAR; PG8_SCHED;
      PG8_LDB(B1, 0, 1); PG8_STAGE(PG8_SB(0, 0), b2, voffA);
      PG8_BAR; PG8_WAIT_L(0); PG8_MMA(0, 1, At, B1); PG8_BAR;
      PG8_LDA(At, 0, 1); PG8_STAGE(PG8_SA(0, 0), a2, voffA);
      PG8_BAR; PG8_WAIT_L(0); PG8_MMA(1, 0, At, B0); PG8_BAR; PG8_SCHED;
      PG8_STAGE(PG8_SB(0, 1), b2 + hstep, voffA);
      PG8_WAIT_V(6); PG8_BAR; PG8_MMA(1, 1, At, B1); PG8_BAR;
      PG8_LDB(B0, 1, 0); PG8_SCHED; PG8_LDA(At, 1, 0); PG8_STAGE(PG8_SA(0, 1), a2 + hstep, voffA);
      PG8_WAIT_L(8); PG8_BAR; PG8_WAIT_L(0); PG8_MMA(0, 0, At, B0); PG8_BAR; PG8_SCHED;
      PG8_LDB(B1, 1, 1); PG8_STAGE(PG8_SB(1, 0), b3, voffA);
      PG8_BAR; PG8_WAIT_L(0); PG8_MMA(0, 1, At, B1); PG8_BAR;
      PG8_LDA(At, 1, 1); PG8_STAGE(PG8_SA(1, 0), a3, voffA);
      PG8_BAR; PG8_WAIT_L(0); PG8_MMA(1, 0, At, B0); PG8_BAR; PG8_SCHED;
      PG8_STAGE(PG8_SB(1, 1), b3 + hstep, voffA);
      PG8_WAIT_V(6); PG8_BAR; PG8_MMA(1, 1, At, B1); PG8_BAR;
    }
    E(acc, cur, wr, wc, fr, fq);
    if (!has_next) break;
#pragma unroll
    for (int a = 0; a < 2; ++a)
#pragma unroll
      for (int b = 0; b < 2; ++b)
#pragma unroll
        for (int m = 0; m < 4; ++m)
#pragma unroll
          for (int n = 0; n < 2; ++n) acc[a][b][m][n] = (f32x4){0.f, 0.f, 0.f, 0.f};
    cur = nxt; cA = nA; cB = nB; ++ui;
    nt = cur.ks ? g.nt1 : g.nt0;
  }
  PG8_WAIT_V(0);
  if (wr == 0) PG8_BAR;
  PG8_BAR;
#undef PG8_SA
#undef PG8_SB
#undef PG8_STAGE
#undef PG8_LDA
#undef PG8_LDB
#undef PG8_MMA
#undef PG8_WAIT_V
#undef PG8_WAIT_L
#undef PG8_BAR
#undef PG8_SCHED
}

__device__ __forceinline__ void conv_tile(const Ctx& cx, const float* __restrict__ src, bfu* __restrict__ dst, int K, int N, int kt, int nt, int perm) {
  char* smem = cx.lds;
  float* tile = reinterpret_cast<float*>(smem);
  const int tid = cx.tid;
  const int k0 = kt * 64, n0 = nt * 64;
#pragma unroll
  for (int i = 0; i < 4; ++i) {
    int kk = (tid >> 4) + 16 * i, nn = (tid & 15) * 4;
    float4 v = *reinterpret_cast<const float4*>(src + (size_t)(k0 + kk) * N + n0 + nn);
    tile[kk * 65 + nn] = v.x; tile[kk * 65 + nn + 1] = v.y; tile[kk * 65 + nn + 2] = v.z; tile[kk * 65 + nn + 3] = v.w;
  }
  __syncthreads();
#pragma unroll
  for (int i = 0; i < 2; ++i) {
    int q = tid + 256 * i, nn = q >> 3, kc = q & 7;
    int j = n0 + nn, drow = j;
    if (perm == 1) {
      if (j < DFF) drow = (j >> 4) * 32 + (j & 15);
      else { int jj = j - DFF; drow = (jj >> 4) * 32 + 16 + (jj & 15); }
    } else if (perm == 2) {
      int sec = j >> 9;
      if (sec == 5 || sec == 6 || sec == 9 || sec == 10) {
        int d = j & 63;
        int pos = d < 16 ? d : (d < 32 ? d + 16 : (d < 48 ? d - 16 : d));
        drow = (j & ~63) + pos;
      }
    }
    uint4 o;
    o.x = pack2(tile[(kc * 8 + 0) * 65 + nn], tile[(kc * 8 + 1) * 65 + nn]);
    o.y = pack2(tile[(kc * 8 + 2) * 65 + nn], tile[(kc * 8 + 3) * 65 + nn]);
    o.z = pack2(tile[(kc * 8 + 4) * 65 + nn], tile[(kc * 8 + 5) * 65 + nn]);
    o.w = pack2(tile[(kc * 8 + 6) * 65 + nn], tile[(kc * 8 + 7) * 65 + nn]);
    *reinterpret_cast<uint4*>(dst + (size_t)drow * K + k0 + kc * 8) = o;
  }
  __syncthreads();
}

__device__ __forceinline__ void conv_item(const Ctx& cx, const Params& p, int l, int r) {
  if (r < 11008) {
    int f = r / 5504, rr = r % 5504;
    conv_tile(cx, p.ffn_w_in + (size_t)(l * 2 + f) * 2048 * 11008, reinterpret_cast<bfu*>(p.ws + OFF_WFIN) + (size_t)(l * 2 + f) * 11008 * 2048,
              2048, 11008, rr / 172, rr % 172, 1);
  } else if (r < 16512) {
    r -= 11008;
    int f = r / 2752, rr = r % 2752;
    conv_tile(cx, p.ffn_w_out + (size_t)(l * 2 + f) * 5504 * 2048, reinterpret_cast<bfu*>(p.ws + OFF_WFOUT) + (size_t)(l * 2 + f) * 2048 * 5504,
              5504, 2048, rr / 32, rr % 32, 0);
  } else if (r < 20096) {
    r -= 16512;
    conv_tile(cx, p.w_in + (size_t)l * 2048 * 7168, reinterpret_cast<bfu*>(p.ws + OFF_WIN) + (size_t)l * 7168 * 2048, 2048, 7168, r / 112, r % 112, 2);
  } else {
    r -= 20096;
    conv_tile(cx, p.w_out + (size_t)l * 2048 * 2048, reinterpret_cast<bfu*>(p.ws + OFF_WOUT) + (size_t)l * 2048 * 2048, 2048, 2048, r / 32, r % 32, 0);
  }
}

__device__ __forceinline__ void conv_deferred(const Ctx& cx, const Params& p, int j) {
  int l, r;
  if (j < 2752) { l = 0; r = 11008 + j; }
  else if (j < 6336) { l = 0; r = 16512 + (j - 2752); }
  else if (j < 7360) { l = 0; r = 20096 + (j - 6336); }
  else if (j < 12864) { l = 0; r = 5504 + (j - 7360); }
  else if (j < 15616) { l = 0; r = 13760 + (j - 12864); }
  else if (j < 21120) { l = 1; r = (j - 15616); }
  else if (j < 23872) { l = 1; r = 11008 + (j - 21120); }
  else if (j < 27456) { l = 1; r = 16512 + (j - 23872); }
  else if (j < 28480) { l = 1; r = 20096 + (j - 27456); }
  else if (j < 33984) { l = 1; r = 5504 + (j - 28480); }
  else { l = 1; r = 13760 + (j - 33984); }
  conv_item(cx, p, l, r);
}

__device__ __forceinline__ void phase0(const Ctx& cx, const Params& p) {
  char* smem = cx.lds;
  const int tid = cx.tid;
  constexpr int N_MODP = 2 * 18 * KS_MOD;
  constexpr int N_ROPE = 256;
  constexpr int N_CONV = 5504;
  unsigned* p0ctr = reinterpret_cast<unsigned*>(p.ws + OFF_BAR) + 3520 + 6 * 64;
  volatile LAS unsigned* p0bc = (volatile LAS unsigned*)((LAS unsigned char*)(smem - (cx.vb & 1) * 65536) + 131072 + 8);
  for (;;) {
    __syncthreads();
    if ((cx.vb & 1) == 0 && tid == 0) p0bc[0] = __hip_atomic_fetch_add(p0ctr, 2u, __ATOMIC_RELAXED, __HIP_MEMORY_SCOPE_AGENT);
    __syncthreads();
    const int it = (int)p0bc[0] + (cx.vb & 1);
    if (it >= N_MODP + N_ROPE + N_CONV) break;
    if (it < N_MODP) {
      int ks = it % KS_MOD, t = it / KS_MOD, cb = t % 18, l = t / 18;
      float* cs = reinterpret_cast<float*>(smem);
      constexpr int KC = DM / KS_MOD;
      for (int i = tid; i < 5 * KC; i += NT) {
        int v = i / KC, k = i % KC;
        float cv = (v < 4) ? p.c[v * DM + ks * KC + k] : p.c_ctx[ks * KC + k];
        cs[i] = siluf_(cv);
      }
      __syncthreads();
      int col = cb * 1024 + tid * 4;
      float4 acc[5];
#pragma unroll
      for (int v = 0; v < 5; ++v) acc[v] = make_float4(0.f, 0.f, 0.f, 0.f);
      const float* wp = p.w_ada + ((size_t)l * DM + ks * KC) * NMOD + col;
#pragma unroll 4
      for (int k = 0; k < KC; ++k) {
        float4 w = *reinterpret_cast<const float4*>(wp + (size_t)k * NMOD);
#pragma unroll
        for (int v = 0; v < 5; ++v) {
          float s = cs[v * KC + k];
          acc[v].x += s * w.x; acc[v].y += s * w.y; acc[v].z += s * w.z; acc[v].w += s * w.w;
        }
      }
      float* mp = reinterpret_cast<float*>(p.ws + OFF_MODP);
#pragma unroll
      for (int v = 0; v < 5; ++v) *reinterpret_cast<float4*>(mp + ((size_t)(l * KS_MOD + ks) * 5 + v) * NMOD + col) = acc[v];
      __syncthreads();
    } else if (it < N_MODP + N_ROPE) {
      int idx = (it - N_MODP) * 256 + tid;
      int tl = idx >> 5, i = idx & 31;
      float inv = powf(10000.f, -(float)(i & 15) / 16.f);
      float pos = (i < 16) ? (float)(tl >> 6) : (float)(tl & 63);
      float ang = pos * inv;
      float2 cssn = make_float2(__cosf(ang), __sinf(ang));
      reinterpret_cast<float2*>(p.ws + OFF_ROPE)[idx] = cssn;
    } else {
      int idx = it - N_MODP - N_ROPE;
      conv_item(cx, p, 0, idx);
    }
  }
}

__device__ __forceinline__ void phase_modreduce(const Ctx& cx, const Params& p) {
  const float* mp = reinterpret_cast<const float*>(p.ws + OFF_MODP);
  float* mod = reinterpret_cast<float*>(p.ws + OFF_MOD);
  for (int idx = cx.vb * NT + cx.tid; idx < 2 * 5 * NMOD; idx += cx.vg * NT) {
    int col = idx % NMOD, t = idx / NMOD, v = t % 5, l = t / 5;
    float s = p.b_ada[l * NMOD + col];
    for (int ks = 0; ks < KS_MOD; ++ks) s += mp[((size_t)(l * KS_MOD + ks) * 5 + v) * NMOD + col];
    mod[idx] = s;
  }
}

struct NormArgs {
  int first;
  const bfu* y;
  const bfu* y2;
  const float* gate;
  const float* post;
  float rs;
  const float* pre;
  const float* shift;
  const float* scale;
  int write_out;
  int skip_ctx;
};
__device__ __forceinline__ void norm_phase(const Ctx& cx, const Params& p, NormArgs a) {
  const int wid = cx.tid >> 6, lane = cx.tid & 63;
  bfu* H = reinterpret_cast<bfu*>(p.ws + OFF_H);
  bfu* U = reinterpret_cast<bfu*>(p.ws + OFF_U);
  float* PL = reinterpret_cast<float*>(cx.lds);
  const int total = a.skip_ctx ? 4 * 2048 : NROW;
  const int rows_per = (total + cx.vg - 1) / cx.vg;
  const int q0 = cx.vb * rows_per, q1 = min(q0 + rows_per, total);
  auto row_of = [&](int q) { return a.skip_ctx ? ((q >> 11) * TPB + 256 + (q & 2047)) : q; };
  int v0 = 0, v1 = 0;
  if (q0 < q1) {
    const int ra = row_of(q0), rb = row_of(q1 - 1);
    v0 = (ra % TPB) < 256 ? 4 : ra / TPB;
    v1 = (rb % TPB) < 256 ? 4 : rb / TPB;
  }
  for (int i = cx.tid; i < 512; i += NT) {
    const int c = i * 4;
    if (a.y) {
      *reinterpret_cast<float4*>(PL + c) = *reinterpret_cast<const float4*>(a.post + c);
      *reinterpret_cast<float4*>(PL + 4096 + c) = *reinterpret_cast<const float4*>(a.gate + (size_t)v0 * NMOD + c);
      if (v1 != v0) *reinterpret_cast<float4*>(PL + 4096 + 6144 + c) = *reinterpret_cast<const float4*>(a.gate + (size_t)v1 * NMOD + c);
    }
    if (a.pre) {
      *reinterpret_cast<float4*>(PL + 2048 + c) = *reinterpret_cast<const float4*>(a.pre + c);
      *reinterpret_cast<float4*>(PL + 4096 + 2048 + c) = *reinterpret_cast<const float4*>(a.shift + (size_t)v0 * NMOD + c);
      *reinterpret_cast<float4*>(PL + 4096 + 4096 + c) = *reinterpret_cast<const float4*>(a.scale + (size_t)v0 * NMOD + c);
      if (v1 != v0) {
        *reinterpret_cast<float4*>(PL + 4096 + 6144 + 2048 + c) = *reinterpret_cast<const float4*>(a.shift + (size_t)v1 * NMOD + c);
        *reinterpret_cast<float4*>(PL + 4096 + 6144 + 4096 + c) = *reinterpret_cast<const float4*>(a.scale + (size_t)v1 * NMOD + c);
      }
    }
  }
  __syncthreads();
  for (int q = q0 + wid; q < q1; q += 4) {
    const int row = row_of(q);
    int b = row / TPB, t = row % TPB;
    int v = t < 256 ? 4 : b;
    const float* PS = PL + 4096 + (v == v0 ? 0 : 6144);
    float4 h[8];
    if (a.first) {
      const float* src = t < 256 ? p.ctx + ((size_t)b * 256 + t) * DM : p.x + ((size_t)b * 2048 + (t - 256)) * DM;
#pragma unroll
      for (int i = 0; i < 8; ++i) h[i] = *reinterpret_cast<const float4*>(src + i * 256 + lane * 4);
    } else {
#pragma unroll
      for (int i = 0; i < 8; ++i) {
        uint2 hb = *reinterpret_cast<const uint2*>(H + (size_t)row * DM + i * 256 + lane * 4);
        h[i].x = __uint_as_float(hb.x << 16); h[i].y = __uint_as_float(hb.x & 0xffff0000u);
        h[i].z = __uint_as_float(hb.y << 16); h[i].w = __uint_as_float(hb.y & 0xffff0000u);
      }
    }
    if (a.y) {
      float4 y[8];
      float ss = 0.f;
#pragma unroll
      for (int i = 0; i < 8; ++i) {
        {
          uint2 yb = *reinterpret_cast<const uint2*>(a.y + (size_t)row * DM + i * 256 + lane * 4);
          y[i].x = __uint_as_float(yb.x << 16); y[i].y = __uint_as_float(yb.x & 0xffff0000u);
          y[i].z = __uint_as_float(yb.y << 16); y[i].w = __uint_as_float(yb.y & 0xffff0000u);
        }
        if (a.y2) {
          uint2 yb = *reinterpret_cast<const uint2*>(a.y2 + (size_t)row * DM + i * 256 + lane * 4);
          y[i].x += __uint_as_float(yb.x << 16); y[i].y += __uint_as_float(yb.x & 0xffff0000u);
          y[i].z += __uint_as_float(yb.y << 16); y[i].w += __uint_as_float(yb.y & 0xffff0000u);
        }
        ss += y[i].x * y[i].x + y[i].y * y[i].y + y[i].z * y[i].z + y[i].w * y[i].w;
      }
      ss = wave_sum(ss);
      float ry = rsqrtf(ss * (1.f / DM) + EPS) * a.rs;
#pragma unroll
      for (int i = 0; i < 8; ++i) {
        int c = i * 256 + lane * 4;
        float4 g = *reinterpret_cast<const float4*>(PS + c);
        float4 po = *reinterpret_cast<const float4*>(PL + c);
        h[i].x += g.x * (y[i].x * ry * po.x);
        h[i].y += g.y * (y[i].y * ry * po.y);
        h[i].z += g.z * (y[i].z * ry * po.z);
        h[i].w += g.w * (y[i].w * ry * po.w);
      }
    }
    if (a.first || a.y) {
#pragma unroll
      for (int i = 0; i < 8; ++i) {
        uint2 hb; hb.x = pack2(h[i].x, h[i].y); hb.y = pack2(h[i].z, h[i].w);
        *reinterpret_cast<uint2*>(H + (size_t)row * DM + i * 256 + lane * 4) = hb;
      }
    }
    if (a.write_out && t >= 256) {
      float* o = p.out + ((size_t)b * 2048 + (t - 256)) * DM;
#pragma unroll
      for (int i = 0; i < 8; ++i) *reinterpret_cast<float4*>(o + i * 256 + lane * 4) = h[i];
    }
    if (a.pre) {
      float ss = 0.f;
#pragma unroll
      for (int i = 0; i < 8; ++i) ss += h[i].x * h[i].x + h[i].y * h[i].y + h[i].z * h[i].z + h[i].w * h[i].w;
      ss = wave_sum(ss);
      float rh = rsqrtf(ss * (1.f / DM) + EPS);
#pragma unroll
      for (int i = 0; i < 8; ++i) {
        int c = i * 256 + lane * 4;
        float4 pr = *reinterpret_cast<const float4*>(PL + 2048 + c);
        float4 sh = *reinterpret_cast<const float4*>(PS + 2048 + c);
        float4 sc = *reinterpret_cast<const float4*>(PS + 4096 + c);
        uint2 o;
        o.x = pack2((h[i].x * rh * pr.x) * (1.f + sc.x) + sh.x, (h[i].y * rh * pr.y) * (1.f + sc.y) + sh.y);
        o.y = pack2((h[i].z * rh * pr.z) * (1.f + sc.z) + sh.z, (h[i].w * rh * pr.w) * (1.f + sc.w) + sh.w);
        *reinterpret_cast<uint2*>(U + (size_t)row * DM + c) = o;
      }
    }
  }
}

__device__ __forceinline__ float lower_bound(const Params& p, int l, int dir, int c) {
  if (l == 0) return 0.f;
  float a0 = p.lb_logits[(0 * 2 + dir) * 512 + c], a1 = p.lb_logits[(1 * 2 + dir) * 512 + c];
  float mx = fmaxf(a0, a1);
  float e0 = __expf(a0 - mx), e1 = __expf(a1 - mx);
  return e1 / (e0 + e1);
}

using bf16x4 = __attribute__((ext_vector_type(4))) short;
using u32x2 = __attribute__((ext_vector_type(2))) unsigned;
__device__ __forceinline__ f32x4 mfma16k(bf16x4 a, bf16x4 b, f32x4 c, int, int, int) {
  const bf16x8 a8 = (bf16x8){a[0], a[1], a[2], a[3], 0, 0, 0, 0};
  const bf16x8 b8 = (bf16x8){b[0], b[1], b[2], b[3], 0, 0, 0, 0};
  return __builtin_amdgcn_mfma_f32_16x16x32_bf16(a8, b8, c, 0, 0, 0);
}
__device__ __forceinline__ bfu f2bf_hw(float x) { return (bfu)(pack2(x, x) & 0xffffu); }

__device__ __forceinline__ void gla_pass1(const Ctx& cx, const Params& p, int l, int item, float* ldsf, int lane) {
  int n = item % 36, t = item / 36;
  int dir = t & 1; t >>= 1;
  int h = t & 7; t >>= 3;
  int b = t & 3, m = t >> 2;
  int tb = dir == 0 ? n : (n < 4 ? 3 - n : 39 - n);
  const float* z = reinterpret_cast<const float*>(p.ws + OFF_Z);
  const int rowbase = b * TPB + tb * 64;
  const int hc = h * 64 + lane;
  const int c = lane & 15, g = lane >> 4;
  const float lb = (m == 0) ? lower_bound(p, l, dir, hc) : 0.f;
  const float fconst = 1.f - exp2f(-5.f - (float)h);
  const int c0off = (m == 0) ? (dir ? 1024 : 512) : 3072;
  const int c1off = (m == 0) ? 1536 : 3584;
  char* L = reinterpret_cast<char*>(ldsf);
  bfu* KTs = reinterpret_cast<bfu*>(L + 4352);
  bfu* VTs = reinterpret_cast<bfu*>(L + 6912);
  float* gs = reinterpret_cast<float*>(L + 9472);
  f32x4 T[4][4];
#pragma unroll
  for (int db = 0; db < 4; ++db)
#pragma unroll
    for (int vb = 0; vb < 4; ++vb) T[db][vb] = (f32x4){0.f, 0.f, 0.f, 0.f};
  float gacc = 1.f;
  float r0[16], r1[16];
#pragma unroll
  for (int i = 0; i < 16; ++i) {
    int tok = dir ? 63 - i : i;
    const float* zr = z + (size_t)(rowbase + tok) * INW;
    r0[i] = zr[c0off + hc];
    r1[i] = zr[c1off + hc];
  }
#pragma unroll 1
  for (int sub = 0; sub < 4; ++sub) {
    {
      float kt[16];
      float e = 1.f;
#pragma unroll
      for (int i = 0; i < 16; ++i) {
        float f, k;
        if (m == 0) { f = r0[i]; k = 1.f - f; }
        else { f = fconst; k = r0[i]; }
        e = fmaxf(e * f, 1e-26f);
        kt[i] = k * __builtin_amdgcn_rcpf(e);
      }
      const float gdec = e;
      gacc *= gdec;
      gs[lane] = gdec;
#pragma unroll
      for (int q = 0; q < 4; ++q) {
        u32x2 kk, vv;
        kk.x = pack2(kt[4 * q] * gdec, kt[4 * q + 1] * gdec); kk.y = pack2(kt[4 * q + 2] * gdec, kt[4 * q + 3] * gdec);
        vv.x = pack2(r1[4 * q], r1[4 * q + 1]); vv.y = pack2(r1[4 * q + 2], r1[4 * q + 3]);
        *reinterpret_cast<u32x2*>(KTs + lane * 20 + 4 * q) = kk;
        *reinterpret_cast<u32x2*>(VTs + lane * 20 + 4 * q) = vv;
      }
    }
    wave_fence();
    if (sub < 3) {
#pragma unroll
      for (int i = 0; i < 16; ++i) {
        int s = (sub + 1) * 16 + i;
        int tok = dir ? 63 - s : s;
        const float* zr = z + (size_t)(rowbase + tok) * INW;
        r0[i] = zr[c0off + hc];
        r1[i] = zr[c1off + hc];
      }
    }
    {
      bf16x4 vA[4];
#pragma unroll
      for (int vb = 0; vb < 4; ++vb) vA[vb] = __builtin_bit_cast(bf16x4, *reinterpret_cast<const u32x2*>(VTs + (16 * vb + c) * 20 + 4 * g));
#pragma unroll
      for (int db = 0; db < 4; ++db) {
        const f32x4 g4 = *reinterpret_cast<const f32x4*>(gs + 16 * db + 4 * g);
        const bf16x4 ktA = __builtin_bit_cast(bf16x4, *reinterpret_cast<const u32x2*>(KTs + (16 * db + c) * 20 + 4 * g));
#pragma unroll
        for (int vb = 0; vb < 4; ++vb) T[db][vb] = mfma16k(ktA, vA[vb], T[db][vb] * g4, 0, 0, 0);
      }
    }
    wave_fence();
  }
  bfu* U = reinterpret_cast<bfu*>(p.ws + OFF_GU) + (size_t)item * 4096;
#pragma unroll
  for (int db = 0; db < 4; ++db)
#pragma unroll
    for (int vb = 0; vb < 4; ++vb) {
      const f32x4 tv = T[db][vb];
      *reinterpret_cast<u32x2*>(U + (16 * vb + c) * 64 + 16 * db + 4 * g) = (u32x2){pack2(tv[0], tv[1]), pack2(tv[2], tv[3])};
    }
  reinterpret_cast<float*>(p.ws + OFF_GG)[(size_t)item * 64 + lane] = gacc;
}

__device__ __forceinline__ void gla_pass2(const Ctx& cx, const Params& p) {
  u32x2* U = reinterpret_cast<u32x2*>(p.ws + OFF_GU);
  const float* G = reinterpret_cast<const float*>(p.ws + OFF_GG);
  for (int idx = cx.vb * NT + cx.tid; idx < 128 * 1024; idx += cx.vg * NT) {
    const int c = idx >> 10, e4 = idx & 1023, d0 = (4 * e4) & 63;
    f32x4 S = (f32x4){0.f, 0.f, 0.f, 0.f};
#pragma unroll 4
    for (int n = 0; n < 36; ++n) {
      const size_t o = ((size_t)(c * 36 + n) << 10) + e4;
      const u32x2 uu = U[o];
      const f32x4 gg = *reinterpret_cast<const f32x4*>(G + (size_t)(c * 36 + n) * 64 + d0);
      U[o] = (u32x2){pack2(S[0], S[1]), pack2(S[2], S[3])};
      const f32x4 uv = (f32x4){__uint_as_float(uu.x << 16), __uint_as_float(uu.x & 0xffff0000u), __uint_as_float(uu.y << 16), __uint_as_float(uu.y & 0xffff0000u)};
      S = gg * S + uv;
    }
  }
}

__device__ __forceinline__ void gla_pass3(const Ctx& cx, const Params& p, int l, int item, float* ldsf, int lane) {
  int tb, t;
  if (l == 1) { tb = 4 + (item & 31); t = item >> 5; } else { tb = item % 36; t = item / 36; }
  int h = t & 7; t >>= 3;
  int b = t & 3, m = t >> 2;
  const float* z = reinterpret_cast<const float*>(p.ws + OFF_Z);
  float* ofwd = reinterpret_cast<float*>(p.ws + OFF_OFWD);
  bfu* mix = reinterpret_cast<bfu*>(p.ws + OFF_MIX);
  const int rowbase = b * TPB + tb * 64;
  const int hc = h * 64 + lane;
  const int c = lane & 15, g = lane >> 4;
  const int dg = g, vg = c;
  const int ocol = m * 512 + h * 64 + vg * 4;
  const f32x4 gain4 = *reinterpret_cast<const f32x4*>((m == 0 ? p.a_norm : p.b_norm) + l * 64 + vg * 4);
  const float fconst = 1.f - exp2f(-5.f - (float)h);
  const int cqoff = (m == 0) ? 0 : 2560;
  const int cvoff = (m == 0) ? 1536 : 3584;
  const int cgoff = (m == 0) ? 2048 : 4096;
  char* L = reinterpret_cast<char*>(ldsf);
  bfu* Qs = reinterpret_cast<bfu*>(L);
  bfu* Ks = reinterpret_cast<bfu*>(L + 2176);
  bfu* KTs = reinterpret_cast<bfu*>(L + 4352);
  bfu* VTs = reinterpret_cast<bfu*>(L + 6912);
  float* gs = reinterpret_cast<float*>(L + 9472);
#pragma unroll 1
  for (int dir = 0; dir < 2; ++dir) {
    int n = dir == 0 ? tb : (tb < 4 ? 3 - tb : 39 - tb);
    int chain = ((m * 4 + b) * 8 + h) * 2 + dir;
    const bfu* Sp = reinterpret_cast<const bfu*>(p.ws + OFF_GU) + ((size_t)(chain * 36 + n) << 12);
    const float lb = (m == 0) ? lower_bound(p, l, dir, hc) : 0.f;
    const int cfoff = (m == 0) ? (dir ? 1024 : 512) : 3072;
    f32x4 T[4][4];
#pragma unroll
    for (int db = 0; db < 4; ++db)
#pragma unroll
      for (int vb = 0; vb < 4; ++vb) {
        const u32x2 sv = *reinterpret_cast<const u32x2*>(Sp + (16 * vb + c) * 64 + 16 * db + 4 * g);
        T[db][vb] = (f32x4){__uint_as_float(sv.x << 16), __uint_as_float(sv.x & 0xffff0000u), __uint_as_float(sv.y << 16), __uint_as_float(sv.y & 0xffff0000u)};
      }
    float r0[16], r1[16], r2[16];
#pragma unroll
    for (int i = 0; i < 16; ++i) {
      int tok = dir ? 63 - i : i;
      const float* zr = z + (size_t)(rowbase + tok) * INW;
      r0[i] = zr[cfoff + hc];
      r1[i] = zr[cqoff + hc];
      r2[i] = zr[cvoff + hc];
    }
#pragma unroll 1
    for (int sub = 0; sub < 4; ++sub) {
      {
        float kt[16];
        float e = 1.f;
#pragma unroll
        for (int i = 0; i < 16; ++i) {
          float f, k, q;
          if (m == 0) { f = r0[i]; k = 1.f - f; q = r1[i]; }
          else { f = fconst; k = r0[i]; q = r1[i]; }
          e = fmaxf(e * f, 1e-26f);
          const float ie = __builtin_amdgcn_rcpf(e);
          kt[i] = k * ie;
          Qs[i * 68 + lane] = f2bf_hw(q * e);
          Ks[i * 68 + lane] = f2bf_hw(kt[i]);
        }
        const float gdec = e;
        gs[lane] = gdec;
#pragma unroll
        for (int q = 0; q < 4; ++q) {
          u32x2 kk, vv;
          kk.x = pack2(kt[4 * q] * gdec, kt[4 * q + 1] * gdec); kk.y = pack2(kt[4 * q + 2] * gdec, kt[4 * q + 3] * gdec);
          vv.x = pack2(r2[4 * q], r2[4 * q + 1]); vv.y = pack2(r2[4 * q + 2], r2[4 * q + 3]);
          *reinterpret_cast<u32x2*>(KTs + lane * 20 + 4 * q) = kk;
          *reinterpret_cast<u32x2*>(VTs + lane * 20 + 4 * q) = vv;
        }
      }
      wave_fence();
      if (sub < 3) {
#pragma unroll
        for (int i = 0; i < 16; ++i) {
          int s = (sub + 1) * 16 + i;
          int tok = dir ? 63 - s : s;
          const float* zr = z + (size_t)(rowbase + tok) * INW;
          r0[i] = zr[cfoff + hc];
          r1[i] = zr[cqoff + hc];
          r2[i] = zr[cvoff + hc];
        }
      }
      {
        bf16x8 qB[2], kA[2];
#pragma unroll
        for (int ks = 0; ks < 2; ++ks) {
          const u32x2 qlo = *reinterpret_cast<const u32x2*>(Qs + c * 68 + 32 * ks + 4 * g);
          const u32x2 qhi = *reinterpret_cast<const u32x2*>(Qs + c * 68 + 32 * ks + 16 + 4 * g);
          const u32x2 klo = *reinterpret_cast<const u32x2*>(Ks + c * 68 + 32 * ks + 4 * g);
          const u32x2 khi = *reinterpret_cast<const u32x2*>(Ks + c * 68 + 32 * ks + 16 + 4 * g);
          qB[ks] = __builtin_bit_cast(bf16x8, (u32x4){qlo.x, qlo.y, qhi.x, qhi.y});
          kA[ks] = __builtin_bit_cast(bf16x8, (u32x4){klo.x, klo.y, khi.x, khi.y});
        }
        f32x4 AT = (f32x4){0.f, 0.f, 0.f, 0.f};
        AT = __builtin_amdgcn_mfma_f32_16x16x32_bf16(kA[0], qB[0], AT, 0, 0, 0);
        AT = __builtin_amdgcn_mfma_f32_16x16x32_bf16(kA[1], qB[1], AT, 0, 0, 0);
#pragma unroll
        for (int r = 0; r < 4; ++r) AT[r] = (4 * g + r <= c) ? AT[r] : 0.f;
        const bf16x4 pB = __builtin_bit_cast(bf16x4, (u32x2){pack2(AT[0], AT[1]), pack2(AT[2], AT[3])});
        bf16x4 vA[4];
#pragma unroll
        for (int vb = 0; vb < 4; ++vb) vA[vb] = __builtin_bit_cast(bf16x4, *reinterpret_cast<const u32x2*>(VTs + (16 * vb + c) * 20 + 4 * g));
        const int tokc = dir ? 63 - (sub * 16 + c) : (sub * 16 + c);
        float* orow = ofwd + ((size_t)dir * NROW + (size_t)(rowbase + tokc)) * 1024 + m * 512 + h * 64 + 4 * g;
#pragma unroll
        for (int vb = 0; vb < 4; ++vb) {
          f32x4 OT = (f32x4){0.f, 0.f, 0.f, 0.f};
          OT = mfma16k(vA[vb], pB, OT, 0, 0, 0);
#pragma unroll
          for (int ks = 0; ks < 2; ++ks) {
            const u32x4 sp = (u32x4){pack2(T[2 * ks][vb][0], T[2 * ks][vb][1]), pack2(T[2 * ks][vb][2], T[2 * ks][vb][3]),
                                     pack2(T[2 * ks + 1][vb][0], T[2 * ks + 1][vb][1]), pack2(T[2 * ks + 1][vb][2], T[2 * ks + 1][vb][3])};
            OT = __builtin_amdgcn_mfma_f32_16x16x32_bf16(__builtin_bit_cast(bf16x8, sp), qB[ks], OT, 0, 0, 0);
          }
          *reinterpret_cast<f32x4*>(orow + 16 * vb) = OT;
        }
#pragma unroll
        for (int db = 0; db < 4; ++db) {
          const f32x4 g4 = *reinterpret_cast<const f32x4*>(gs + 16 * db + 4 * g);
          const bf16x4 ktA = __builtin_bit_cast(bf16x4, *reinterpret_cast<const u32x2*>(KTs + (16 * db + c) * 20 + 4 * g));
#pragma unroll
          for (int vb = 0; vb < 4; ++vb) T[db][vb] = mfma16k(ktA, vA[vb], T[db][vb] * g4, 0, 0, 0);
        }
      }
      wave_fence();
    }
  }
  asm volatile("s_waitcnt vmcnt(0)" ::: "memory");
#pragma unroll 1
  for (int i0 = 0; i0 < 16; i0 += 8) {
    f32x4 of[8], ob[8], gz[8];
#pragma unroll
    for (int i = 0; i < 8; ++i) {
      const size_t row = (size_t)(rowbase + dg + 4 * (i0 + i));
      of[i] = *reinterpret_cast<const f32x4*>(ofwd + row * 1024 + ocol);
      ob[i] = *reinterpret_cast<const f32x4*>(ofwd + ((size_t)NROW + row) * 1024 + ocol);
      gz[i] = *reinterpret_cast<const f32x4*>(z + row * INW + cgoff + h * 64 + vg * 4);
    }
#pragma unroll
    for (int i = 0; i < 8; ++i) {
      const size_t row = (size_t)(rowbase + dg + 4 * (i0 + i));
      const f32x4 o4 = of[i] + ob[i];
      float ss = o4[0] * o4[0] + o4[1] * o4[1] + o4[2] * o4[2] + o4[3] * o4[3];
      ss += __shfl_xor(ss, 1);
      ss += __shfl_xor(ss, 2);
      ss += __shfl_xor(ss, 4);
      ss += __shfl_xor(ss, 8);
      const float rn = rsqrtf(ss * (1.f / 64.f) + EPS);
      uint2 o;
      o.x = pack2(o4[0] * rn * gain4[0] * gz[i][0], o4[1] * rn * gain4[1] * gz[i][1]);
      o.y = pack2(o4[2] * rn * gain4[2] * gz[i][2], o4[3] * rn * gain4[3] * gz[i][3]);
      *reinterpret_cast<uint2*>(mix + row * DM + ocol) = o;
    }
  }
}

__device__ __forceinline__ void rg_load_w(const Ctx& cx, const Params& p, int l, int g) {
  bfu* wl = reinterpret_cast<bfu*>(cx.lds + 26624);
  const int c = cx.tid & 63, tq = cx.tid >> 6;
#pragma unroll
  for (int t = 0; t < 4; ++t) {
    const float* w = ((t & 1) ? p.d_w_i : p.d_w_r) + ((size_t)(l * 2 + (t >> 1)) * 8 + g) * 4096 + c;
#pragma unroll
    for (int ii = 0; ii < 16; ++ii) {
      const int i = tq * 16 + ii;
      wl[(t * 64 + c) * 72 + i] = f2bf_hw(w[i * 64]);
    }
  }
}

__device__ __forceinline__ void rg_d1(const Ctx& cx, const Params& p, int l, int item) {
  char* smem = cx.lds;
  float* xcf = reinterpret_cast<float*>(smem);
  bfu* xcb = reinterpret_cast<bfu*>(smem + 17408);
  const bfu* wl = reinterpret_cast<const bfu*>(smem + 26624);
  int g = item & 7, t = item >> 3;
  int tb = t % 36, b = t / 36;
  const int tid = cx.tid, c = tid & 63, tq = tid >> 6;
  const float* z = reinterpret_cast<const float*>(p.ws + OFF_Z);
  const int seg_lo = tb < 4 ? 0 : 256, seg_hi = tb < 4 ? 256 : TPB;
  {
    const int ch = g * 64 + c;
    float cw[4];
#pragma unroll
    for (int j = 0; j < 4; ++j) cw[j] = p.d_conv_w[(l * 4 + j) * 512 + ch];
    const float cb = p.d_conv_b[l * 512 + ch];
    const int tok0 = tb * 64 + tq * 16;
    float win[19];
#pragma unroll
    for (int i = 0; i < 19; ++i) {
      int tt = tok0 - 1 + i;
      win[i] = (tt >= seg_lo && tt < seg_hi) ? z[(size_t)(b * TPB + tt) * INW + 6144 + ch] : 0.f;
    }
#pragma unroll
    for (int i = 0; i < 16; ++i) {
      const float x = cb + cw[0] * win[i] + cw[1] * win[i + 1] + cw[2] * win[i + 2] + cw[3] * win[i + 3];
      xcf[(tq * 16 + i) * 68 + c] = x;
      xcb[(tq * 16 + i) * 72 + c] = f2bf_hw(x);
    }
  }
  __syncthreads();
  const int lane = tid & 63, c16 = lane & 15, g4 = lane >> 4;
  f32x4 pre[4][4];
  {
    bf16x8 aF[2];
#pragma unroll
    for (int ks = 0; ks < 2; ++ks) aF[ks] = *reinterpret_cast<const bf16x8*>(xcb + (tq * 16 + c16) * 72 + ks * 32 + g4 * 8);
#pragma unroll
    for (int ty = 0; ty < 4; ++ty)
#pragma unroll
      for (int cbk = 0; cbk < 4; ++cbk) {
        f32x4 acc = (f32x4){0.f, 0.f, 0.f, 0.f};
#pragma unroll
        for (int ks = 0; ks < 2; ++ks) {
          const bf16x8 bF = *reinterpret_cast<const bf16x8*>(wl + ((ty * 4 + cbk) * 16 + c16) * 72 + ks * 32 + g4 * 8);
          acc = __builtin_amdgcn_mfma_f32_16x16x32_bf16(aF[ks], bF, acc, 0, 0, 0);
        }
        pre[ty][cbk] = acc;
      }
  }
  float2* AU = reinterpret_cast<float2*>(p.ws + OFF_AU);
  float2* PH = reinterpret_cast<float2*>(p.ws + OFF_PH);
  const int tb16 = tb * 4 + tq;
  const int row0 = b * TPB + tb * 64 + tq * 16 + 4 * g4;
#pragma unroll
  for (int cbk = 0; cbk < 4; ++cbk) {
    const int ch = g * 64 + cbk * 16 + c16;
    float xc[4];
#pragma unroll
    for (int r = 0; r < 4; ++r) xc[r] = xcf[(tq * 16 + 4 * g4 + r) * 68 + cbk * 16 + c16];
#pragma unroll
    for (int dir = 0; dir < 2; ++dir) {
      const float br = p.d_b_r[(l * 2 + dir) * 512 + ch], bi = p.d_b_i[(l * 2 + dir) * 512 + ch];
      const float lam = p.d_lambda[(l * 2 + dir) * 512 + ch];
      const float sp = log1pf(__expf(-lam));
      float av[4], uv[4];
#pragma unroll
      for (int r = 0; r < 4; ++r) {
        const float rr = sigmoidf_(pre[dir * 2][cbk][r] + br);
        const float ig = sigmoidf_(pre[dir * 2 + 1][cbk][r] + bi);
        const float la = -8.f * rr * sp;
        av[r] = __expf(la);
        const float y = -2.f * la;
        float om;
        if (y < 0.25f) om = y * (1.f + y * (-0.5f + y * (0.16666667f + y * (-0.041666668f + y * 0.008333334f))));
        else om = -expm1f(-y);
        uv[r] = sqrtf(om) * (ig * xc[r]);
        AU[((size_t)dir * NROW + row0 + r) * 512 + ch] = make_float2(av[r], uv[r]);
      }
      float P4 = 1.f, H4 = 0.f;
#pragma unroll
      for (int s4 = 0; s4 < 4; ++s4) {
        const int r = dir ? 3 - s4 : s4;
        H4 = av[r] * H4 + uv[r];
        P4 *= av[r];
      }
      float P = 1.f, Hh = 0.f;
#pragma unroll
      for (int s4 = 0; s4 < 4; ++s4) {
        const int k = dir ? 3 - s4 : s4;
        const float Pk = __shfl(P4, c16 + 16 * k);
        const float Hk = __shfl(H4, c16 + 16 * k);
        Hh = Pk * Hh + Hk;
        P *= Pk;
      }
      const int n = dir == 0 ? tb16 : (tb16 < 16 ? 15 - tb16 : 159 - tb16);
      if (g4 == 0) PH[((size_t)(b * 2 + dir) * 144 + n) * 512 + ch] = make_float2(P, Hh);
    }
  }
  __syncthreads();
}

__device__ __forceinline__ void rg_d2(const Ctx& cx, const Params& p) {
  float2* PH = reinterpret_cast<float2*>(p.ws + OFF_PH);
  for (int idx = cx.vb * NT + cx.tid; idx < 4096; idx += cx.vg * NT) {
    int ch = idx & 511, bd = idx >> 9;
    float h = 0.f;
    for (int n = 0; n < 144; ++n) {
      size_t o = ((size_t)bd * 144 + n) * 512 + ch;
      float2 ph = PH[o];
      PH[o].y = h;
      h = ph.x * h + ph.y;
    }
  }
}

__device__ __forceinline__ void rg_d3(const Ctx& cx, const Params& p, int l, int idx) {
  const float2* AU = reinterpret_cast<const float2*>(p.ws + OFF_AU);
  const float2* PH = reinterpret_cast<const float2*>(p.ws + OFF_PH);
  const float* z = reinterpret_cast<const float*>(p.ws + OFF_Z);
  bfu* mix = reinterpret_cast<bfu*>(p.ws + OFF_MIX);
  int ch = idx & 511, rg = idx >> 9;
  int b = rg / 144, tb16 = rg % 144;
  if (l == 1 && tb16 < 16) return;
  int row0 = b * TPB + tb16 * 16;
  float hf[16];
  float h = PH[((size_t)(b * 2 + 0) * 144 + tb16) * 512 + ch].y;
#pragma unroll
  for (int i = 0; i < 16; ++i) {
    float2 au = AU[((size_t)(row0 + i)) * 512 + ch];
    h = au.x * h + au.y;
    hf[i] = h;
  }
  int n = tb16 < 16 ? 15 - tb16 : 159 - tb16;
  h = PH[((size_t)(b * 2 + 1) * 144 + n) * 512 + ch].y;
#pragma unroll
  for (int s = 0; s < 16; ++s) {
    int i = 15 - s;
    float2 au = AU[((size_t)NROW + row0 + i) * 512 + ch];
    h = au.x * h + au.y;
    float gz = z[(size_t)(row0 + i) * INW + 6656 + ch];
    mix[(size_t)(row0 + i) * DM + 1536 + ch] = f2bf(gz * (hf[i] + h));
  }
}

__device__ __forceinline__ void attn_item(const int tid, char* smem, const Params& p, int l, int item) {
  char* Ks = smem;
  char* Vs = smem + 18432;
  const int wid = tid >> 6, lane = tid & 63, fr = lane & 15, fq = lane >> 4;
  int qt, bh;
  if (item < 256) { const int x = item & 7, j = item >> 3; bh = x * 2 + (j >> 4); qt = 2 + (j & 15); }
  else { const int r = item - 256, x = r & 7, j = r >> 3; bh = x * 2 + (j >> 1); qt = j & 1; }
  const int hd = bh & 3, b = bh >> 2;
  const int nkt = qt < 2 ? 4 : 36;
  const bfu* Qc = reinterpret_cast<const bfu*>(p.ws + OFF_QC);
  const bfu* Kc = reinterpret_cast<const bfu*>(p.ws + OFF_KC);
  const bfu* Vt = reinterpret_cast<const bfu*>(p.ws + OFF_VT);
  bfu* mix = reinterpret_cast<bfu*>(p.ws + OFF_MIX);
  const float* lv = p.c_lambda + l * 256;
  float d1 = wave_sum(lv[lane] * lv[64 + lane]);
  float d2 = wave_sum(lv[128 + lane] * lv[192 + lane]);
  const float lam_init = 0.8f - 0.6f * expf(-0.3f * (float)l);
  const float lam = expf(d1) - expf(d2) + lam_init;

  const int qrow = b * TPB + qt * 128 + wid * 16 + fr;
  const bfu* qp = Qc + (size_t)qrow * 512 + hd * 128;
  bf16x8 qf[2][2];
#pragma unroll
  for (int h = 0; h < 2; ++h)
#pragma unroll
    for (int ks = 0; ks < 2; ++ks) qf[h][ks] = *reinterpret_cast<const bf16x8*>(qp + h * 64 + ks * 32 + fq * 8);
  f32x4 O[2][8];
#pragma unroll
  for (int h = 0; h < 2; ++h)
#pragma unroll
    for (int vb = 0; vb < 8; ++vb) O[h][vb] = (f32x4){0.f, 0.f, 0.f, 0.f};
  float mrun[2] = {-INFINITY, -INFINITY}, lrun[2] = {0.f, 0.f};

  const bfu* kbase = Kc + (size_t)(b * TPB) * 512 + hd * 128;
  const bfu* vbase = Vt + ((size_t)b * 512 + hd * 128) * TPB;
  const unsigned koff0 = (unsigned)((tid >> 4) * 512 + (tid & 15) * 8), koff1 = koff0 + 32u * 512u;
  const unsigned voff0 = (unsigned)((tid >> 3) * TPB + (tid & 7) * 8), voff1 = voff0 + 64u * (unsigned)TPB;
  const int kl0 = (tid >> 4) * 288 + (tid & 15) * 16;
  const int vq = tid & 7;
  const int vl0 = (tid >> 3) * 288 + ((vq >> 2) * 32 + 2 * (vq & 1) * 8 + ((vq >> 1) & 1) * 4) * 2;
  constexpr int ABUF = 55296;
  u32x4 kr0 = *reinterpret_cast<const u32x4*>(kbase + koff0), kr1 = *reinterpret_cast<const u32x4*>(kbase + koff1);
  u32x4 vr0 = *reinterpret_cast<const u32x4*>(vbase + voff0), vr1 = *reinterpret_cast<const u32x4*>(vbase + voff1);
  __syncthreads();
  *reinterpret_cast<u32x4*>(Ks + kl0) = kr0;
  *reinterpret_cast<u32x4*>(Ks + kl0 + 32 * 288) = kr1;
  *reinterpret_cast<u32x2*>(Vs + vl0) = (u32x2){vr0.x, vr0.y};
  *reinterpret_cast<u32x2*>(Vs + vl0 + 16) = (u32x2){vr0.z, vr0.w};
  *reinterpret_cast<u32x2*>(Vs + vl0 + 64 * 288) = (u32x2){vr1.x, vr1.y};
  *reinterpret_cast<u32x2*>(Vs + vl0 + 64 * 288 + 16) = (u32x2){vr1.z, vr1.w};
  if (nkt > 1) {
    const bfu* kb_ = kbase + (size_t)64 * 512;
    const bfu* vb_ = vbase + 64;
    kr0 = *reinterpret_cast<const u32x4*>(kb_ + koff0); kr1 = *reinterpret_cast<const u32x4*>(kb_ + koff1);
    vr0 = *reinterpret_cast<const u32x4*>(vb_ + voff0); vr1 = *reinterpret_cast<const u32x4*>(vb_ + voff1);
  }
  __syncthreads();
  char* const Ks0 = Ks; char* const Vs0 = Vs;
#pragma unroll 1
  for (int kt = 0; kt < nkt; ++kt) {
    if (kt + 1 < nkt) {
      char* Kd = Ks0 + ((kt + 1) & 1) * ABUF; char* Vd = Vs0 + ((kt + 1) & 1) * ABUF;
      *reinterpret_cast<u32x4*>(Kd + kl0) = kr0;
      *reinterpret_cast<u32x4*>(Kd + kl0 + 32 * 288) = kr1;
      *reinterpret_cast<u32x2*>(Vd + vl0) = (u32x2){vr0.x, vr0.y};
      *reinterpret_cast<u32x2*>(Vd + vl0 + 16) = (u32x2){vr0.z, vr0.w};
      *reinterpret_cast<u32x2*>(Vd + vl0 + 64 * 288) = (u32x2){vr1.x, vr1.y};
      *reinterpret_cast<u32x2*>(Vd + vl0 + 64 * 288 + 16) = (u32x2){vr1.z, vr1.w};
    }
    if (kt + 2 < nkt) {
      const bfu* kb_ = kbase + (size_t)(kt + 2) * 64 * 512;
      const bfu* vb_ = vbase + (kt + 2) * 64;
      kr0 = *reinterpret_cast<const u32x4*>(kb_ + koff0); kr1 = *reinterpret_cast<const u32x4*>(kb_ + koff1);
      vr0 = *reinterpret_cast<const u32x4*>(vb_ + voff0); vr1 = *reinterpret_cast<const u32x4*>(vb_ + voff1);
    }
    Ks = Ks0 + (kt & 1) * ABUF; Vs = Vs0 + (kt & 1) * ABUF;
    f32x4 S[2][4];
#pragma unroll
    for (int h = 0; h < 2; ++h)
#pragma unroll
      for (int kb = 0; kb < 4; ++kb) {
        f32x4 s = (f32x4){0.f, 0.f, 0.f, 0.f};
#pragma unroll
        for (int ks = 0; ks < 2; ++ks) {
          bf16x8 kf = *reinterpret_cast<const bf16x8*>(Ks + (kb * 16 + fr) * 288 + (h * 64 + ks * 32 + fq * 8) * 2);
          s = __builtin_amdgcn_mfma_f32_16x16x32_bf16(kf, qf[h][ks], s, 0, 0, 0);
        }
        S[h][kb] = s;
      }
    bf16x8 pf[2][2];
#pragma unroll
    for (int h = 0; h < 2; ++h) {
      float mx = -INFINITY;
#pragma unroll
      for (int kb = 0; kb < 4; ++kb)
#pragma unroll
        for (int r = 0; r < 4; ++r) mx = fmaxf(mx, S[h][kb][r]);
      mx = fmaxf(mx, __shfl_xor(mx, 16));
      mx = fmaxf(mx, __shfl_xor(mx, 32));
      const float mold = mrun[h];
      const float mnew = fmaxf(mold, mx);
      mrun[h] = mnew;
      float ps = 0.f;
      float pv[4][4];
#pragma unroll
      for (int kb = 0; kb < 4; ++kb)
#pragma unroll
        for (int r = 0; r < 4; ++r) {
          pv[kb][r] = __builtin_amdgcn_exp2f(S[h][kb][r] - mnew);
          ps += pv[kb][r];
        }
      if (__builtin_amdgcn_ballot_w64(mnew > mold) != 0ull) {
        const float alpha = __builtin_amdgcn_exp2f(mold - mnew);
        lrun[h] *= alpha;
#pragma unroll
        for (int vb = 0; vb < 8; ++vb) O[h][vb] *= alpha;
      }
      lrun[h] += ps;
#pragma unroll
      for (int s = 0; s < 2; ++s) {
        u32x4 cv;
        cv.x = pack2(pv[2 * s][0], pv[2 * s][1]);
        cv.y = pack2(pv[2 * s][2], pv[2 * s][3]);
        cv.z = pack2(pv[2 * s + 1][0], pv[2 * s + 1][1]);
        cv.w = pack2(pv[2 * s + 1][2], pv[2 * s + 1][3]);
        pf[h][s] = __builtin_bit_cast(bf16x8, cv);
      }
    }
#pragma unroll
    for (int vb = 0; vb < 8; ++vb)
#pragma unroll
      for (int s = 0; s < 2; ++s) {
        const bf16x8 vf = *reinterpret_cast<const bf16x8*>(Vs + (vb * 16 + fr) * 288 + (32 * s + 8 * fq) * 2);
        O[0][vb] = __builtin_amdgcn_mfma_f32_16x16x32_bf16(vf, pf[0][s], O[0][vb], 0, 0, 0);
        O[1][vb] = __builtin_amdgcn_mfma_f32_16x16x32_bf16(vf, pf[1][s], O[1][vb], 0, 0, 0);
      }
    __syncthreads();
  }
  float linv[2];
#pragma unroll
  for (int h = 0; h < 2; ++h) {
    float lt = lrun[h];
    lt += __shfl_xor(lt, 16);
    lt += __shfl_xor(lt, 32);
    linv[h] = 1.f / lt;
  }
  float ss = 0.f;
  float ov[8][4];
#pragma unroll
  for (int vb = 0; vb < 8; ++vb)
#pragma unroll
    for (int r = 0; r < 4; ++r) {
      float o = O[0][vb][r] * linv[0] - lam * (O[1][vb][r] * linv[1]);
      ov[vb][r] = o;
      ss += o * o;
    }
  ss += __shfl_xor(ss, 16);
  ss += __shfl_xor(ss, 32);
  float rn = rsqrtf(ss * (1.f / 128.f) + EPS) * (1.f - lam_init);
#pragma unroll
  for (int vb = 0; vb < 8; ++vb) {
    int v0 = vb * 16 + 4 * fq;
    float4 g = *reinterpret_cast<const float4*>(p.c_norm + l * 128 + v0);
    uint2 o;
    o.x = pack2(ov[vb][0] * rn * g.x, ov[vb][1] * rn * g.y);
    o.y = pack2(ov[vb][2] * rn * g.z, ov[vb][3] * rn * g.w);
    *reinterpret_cast<uint2*>(mix + (size_t)qrow * DM + 1024 + hd * 128 + v0) = o;
  }
  __syncthreads();
}

__device__ __forceinline__ int opaque(int v) { asm volatile("" : "+v"(v)); return v; }

__device__ __forceinline__ void phase_m1(const int tid512, char* smem, const Params& p, int l) {
  const int N_ATT = (l == 1) ? 256 : 288;
  constexpr int N_GLA = 4608 / 4;
  constexpr int N_RG = 4 * 36 * 8;
  {
    const int tid = opaque(tid512);
#pragma unroll 1
    for (int it = blockIdx.x; it < N_ATT; it += gridDim.x) attn_item(tid, smem, p, l, it);
  }
  const int half = tid512 >> 8;
  const int VG = 2 * (int)gridDim.x;
  {
    Ctx cx; cx.tid = opaque(tid512) & 255; cx.vb = 2 * blockIdx.x + half; cx.vg = VG; cx.lds = smem + half * 65536;
    const int wid = cx.tid >> 6, lane = cx.tid & 63;
    int b0 = cx.vb - 64; if (b0 < 0) b0 += VG;
#pragma unroll 1
    for (int it = b0; it < N_GLA; it += VG) gla_pass1(cx, p, l, it * 4 + wid, reinterpret_cast<float*>(cx.lds) + wid * 4096, lane);
  }
  __syncthreads();
  {
    Ctx cx; cx.tid = opaque(tid512) & 255; cx.vb = 2 * blockIdx.x + half; cx.vg = VG; cx.lds = smem + half * 65536;
    int b0 = cx.vb - 192; if (b0 < 0) b0 += VG;
    rg_load_w(cx, p, l, b0 & 7);
    __syncthreads();
#pragma unroll 1
    for (int it = b0; it < N_RG; it += VG) rg_d1(cx, p, l, it);
  }
}
__device__ __forceinline__ void phase_m2(const Ctx& cx, const Params& p) {
  gla_pass2(cx, p);
  rg_d2(cx, p);
}
__device__ __forceinline__ void phase_m3(const int tid512, char* smem, const Params& p, int l) {
  const int N_GLA = (l == 1) ? 512 : 576;
  constexpr int N_RG = 576 * 512 / NT;
  const int half = tid512 >> 8;
  const int VG = 2 * (int)gridDim.x;
  {
    Ctx cx; cx.tid = opaque(tid512) & 255; cx.vb = 2 * blockIdx.x + half; cx.vg = VG; cx.lds = smem + half * 65536;
    const int wid = cx.tid >> 6, lane = cx.tid & 63;
#pragma unroll 1
    for (int it = cx.vb; it < N_GLA; it += VG) gla_pass3(cx, p, l, it * 4 + wid, reinterpret_cast<float*>(cx.lds) + wid * 4096, lane);
  }
  {
    Ctx cx; cx.tid = opaque(tid512) & 255; cx.vb = 2 * blockIdx.x + half; cx.vg = VG; cx.lds = smem + half * 65536;
    int b0 = cx.vb - 64; if (b0 < 0) b0 += VG;
#pragma unroll 1
    for (int it = b0; it < N_RG; it += VG) rg_d3(cx, p, l, it * NT + cx.tid);
  }
}


#define XB_TMO      128
#define XB_XCNT(j)  (256  + 64 * (j))
#define XB_XSUB(j)  (1280 + 64 * (j))
#define XB_XGEN(j)  (2304 + 64 * (j))
#define XB_TOP      3328
#define XB_TOPGEN   3392
#define XCD_BAR_WORDS 3456
#define XB_SPIN_CAP (1u << 20)
__device__ __forceinline__ unsigned xb_ld(unsigned* p)              { return __hip_atomic_load(p, __ATOMIC_RELAXED, __HIP_MEMORY_SCOPE_AGENT); }
__device__ __forceinline__ unsigned xb_add(unsigned* p, unsigned v) { return __hip_atomic_fetch_add(p, v, __ATOMIC_RELAXED, __HIP_MEMORY_SCOPE_AGENT); }
__device__ __forceinline__ unsigned xb_xcc_id() { return (unsigned)__builtin_amdgcn_s_getreg((3 << 11) | 20) & 0xFu; }
#define XB_SPIN(cond, bar) do { unsigned _sp = 0; while (cond) { __builtin_amdgcn_s_sleep(1); \
    if ((++_sp & 255u) == 0u) { if (xb_ld(&(bar)[XB_TMO])) break; if (_sp > XB_SPIN_CAP) { atomicAdd(&(bar)[XB_TMO], 1u); break; } } } } while (0)
struct XcdBarrier { unsigned* bar; unsigned x; volatile LAS unsigned* st; };
__device__ __forceinline__ XcdBarrier xcd_barrier_post(unsigned* bar, volatile LAS unsigned* st) {
  XcdBarrier b; b.bar = bar; b.x = xb_xcc_id(); b.st = st;
  if (threadIdx.x == 0) (void)xb_add(&bar[XB_XCNT(b.x)], 1u);
  return b;
}
__device__ __forceinline__ void xcd_barrier_complete(unsigned* bar, unsigned x, unsigned& nloc, unsigned& nx) {
  const unsigned G = gridDim.x * gridDim.y * gridDim.z;
  unsigned sum, cnt, mine, sp = 0u;
  for (;;) {
    sum = 0u; cnt = 0u; mine = 0u;
#pragma unroll
    for (unsigned j = 0; j < 16; ++j) { const unsigned c = xb_ld(&bar[XB_XCNT(j)]); sum += c; cnt += (c > 0u) ? 1u : 0u; mine = (j == x) ? c : mine; }
    if (sum == G) break;
    __builtin_amdgcn_s_sleep(1);
    if ((++sp & 255u) == 0u) { if (xb_ld(&bar[XB_TMO])) break; if (sp > XB_SPIN_CAP) { atomicAdd(&bar[XB_TMO], 1u); break; } }
  }
  nloc = mine > 0u ? mine : 1u; nx = cnt > 0u ? cnt : 1u;
}
__device__ __forceinline__ void xcd_barrier(const XcdBarrier& b) {
  asm volatile("s_waitcnt vmcnt(0)" ::: "memory");
  __syncthreads();
  if (threadIdx.x == 0) {
    unsigned* bar = b.bar;
    __builtin_amdgcn_s_waitcnt(0);
    unsigned nloc = b.st[0], nx = b.st[1];
    if (nloc == 0u) { xcd_barrier_complete(bar, b.x, nloc, nx); b.st[0] = nloc; b.st[1] = nx; }
    const unsigned old = xb_add(&bar[XB_XSUB(b.x)], 1u);
    const unsigned gen = old / nloc;
    if (old + 1u == (gen + 1u) * nloc) {
      __builtin_amdgcn_fence(__ATOMIC_RELEASE, "agent");
      asm volatile("s_waitcnt vmcnt(0)" ::: "memory");
      const unsigned og = xb_add(&bar[XB_TOP], 1u);
      const unsigned tg = og / nx;
      if (og + 1u == (tg + 1u) * nx) xb_add(&bar[XB_TOPGEN], 1u);
      else XB_SPIN(xb_ld(&bar[XB_TOPGEN]) == tg, bar);
      __builtin_amdgcn_fence(__ATOMIC_ACQUIRE, "agent");
      xb_add(&bar[XB_XGEN(b.x)], 1u);
      asm volatile("s_waitcnt vmcnt(0)" ::: "memory");
    } else {
      XB_SPIN(xb_ld(&bar[XB_XGEN(b.x)]) == gen, bar);
      __builtin_amdgcn_fence(__ATOMIC_ACQUIRE, "agent");
      asm volatile("s_waitcnt vmcnt(0)" ::: "memory");
    }
  }
  __syncthreads();
}

__device__ __forceinline__ void filler(const int tid512, char* smem, const Params& p, int slot, int lo, int hi) {
  if (lo >= hi) return;
  unsigned* ctr = reinterpret_cast<unsigned*>(p.ws + OFF_BAR) + 3520 + slot * 64;
  volatile LAS unsigned* bc = (volatile LAS unsigned*)((LAS unsigned char*)smem + 131072 + 8);
  const int half = tid512 >> 8;
  Ctx cx; cx.tid = tid512 & 255; cx.vb = 0; cx.vg = 1; cx.lds = smem + half * 65536;
  for (;;) {
    __syncthreads();
    if (tid512 == 0) bc[0] = __hip_atomic_fetch_add(ctr, 2u, __ATOMIC_RELAXED, __HIP_MEMORY_SCOPE_AGENT);
    __syncthreads();
    const int j = lo + (int)bc[0];
    if (j >= hi) break;
    conv_deferred(cx, p, j + half);
  }
}

constexpr int N_PHASES = 3 + 2 * 12;

__device__ __forceinline__ void run_phase(const int tid512, const Params& p, int ph) {
  extern __shared__ __attribute__((aligned(16))) char smem[];
  Ctx cx; cx.tid = tid512 & 255; cx.vb = 2 * blockIdx.x + (tid512 >> 8); cx.vg = 2 * gridDim.x; cx.lds = smem + (tid512 >> 8) * 65536;
  const float* MOD = reinterpret_cast<const float*>(p.ws + OFF_MOD);
  bfu* Y = reinterpret_cast<bfu*>(p.ws + OFF_Y);
  bfu* U = reinterpret_cast<bfu*>(p.ws + OFF_U);
  bfu* ACT = reinterpret_cast<bfu*>(p.ws + OFF_ACT);
  bfu* MIX = reinterpret_cast<bfu*>(p.ws + OFF_MIX);
  if (ph == 0) { phase0(cx, p); return; }
  if (ph == 1) { phase_modreduce(cx, p); return; }
  int l = 0, s = -1;
  if (ph >= 3) { l = (ph - 3) / 12; s = (ph - 3) % 12; }
  const float* modl = MOD + (size_t)l * 5 * NMOD;
  const bfu* Wfin = reinterpret_cast<const bfu*>(p.ws + OFF_WFIN) + (size_t)l * 2 * 11008 * 2048;
  const bfu* Wfout = reinterpret_cast<const bfu*>(p.ws + OFF_WFOUT) + (size_t)l * 2 * 2048 * 5504;
  const bfu* Win = reinterpret_cast<const bfu*>(p.ws + OFF_WIN) + (size_t)l * 7168 * 2048;
  const bfu* Wout = reinterpret_cast<const bfu*>(p.ws + OFF_WOUT) + (size_t)l * 2048 * 2048;
  LAS unsigned char* lds = (LAS unsigned char*)smem;
  int fl_slot = 0, fl_lo = 0, fl_hi = 0;
  if (s == -1 || s == 2 || s == 8 || s == 11) {
    NormArgs a{};
    if (s == -1) {
      a.first = 1; a.y = nullptr; a.y2 = nullptr; a.rs = 0.f; a.gate = MOD; a.post = p.norm_post;
      a.pre = p.norm_pre; a.shift = MOD + 0 * DM; a.scale = MOD + 1 * DM; a.write_out = 0;
    } else {
      int k = (s == 2) ? 0 : (s == 8 ? 1 : 2);
      a.first = 0; a.y = Y; a.y2 = (k == 1) ? nullptr : Y + (size_t)NROW * DM;
      a.gate = modl + (3 * k + 2) * DM; a.post = p.norm_post + (l * 3 + k) * DM;
      a.rs = (k == 1) ? 1.f : 0.5f; a.write_out = 0;
      a.skip_ctx = (l == 1 && k >= 1) ? 1 : 0;
      if (k < 2) {
        a.pre = p.norm_pre + (l * 3 + k + 1) * DM; a.shift = modl + (3 * k + 3) * DM; a.scale = modl + (3 * k + 4) * DM;
      } else if (l == 0) {
        const float* modn = MOD + (size_t)1 * 5 * NMOD;
        a.pre = p.norm_pre + (1 * 3 + 0) * DM; a.shift = modn + 0 * DM; a.scale = modn + 1 * DM;
      } else {
        a.pre = nullptr; a.shift = nullptr; a.scale = nullptr; a.write_out = 1;
      }
    }
    norm_phase(cx, p, a);
  } else if (s == 0 || s == 9) {
    Gemm g; g.A = U; g.Bt = (s == 0) ? Wfin : Wfin + (size_t)11008 * 2048; g.M = NROW; g.N = 11008; g.lda = 2048; g.S = 1; g.nt0 = 32; g.nt1 = 32;
    g.latent_only = (l == 1 && s == 9) ? 1 : 0; if (g.latent_only) g.M = 8192;
    StaticOrder S; S.init(g, gridDim.x, blockIdx.x);
    EpiSwiglu E; E.act = ACT;
    gemm_phase(tid512, lds, g, S, E);
    if (l == 0 && s == 0) { fl_slot = 0; fl_lo = 0; fl_hi = 7360; }
    else if (l == 0 && s == 9) { fl_slot = 3; fl_lo = 19360; fl_hi = 27760; }
    else if (l == 1 && s == 0) { fl_slot = 5; fl_lo = 32060; fl_hi = 36736; }
  } else if (s == 1 || s == 7 || s == 10) {
    Gemm g; g.M = NROW; g.N = 2048;
    g.latent_only = (l == 1 && (s == 7 || s == 10)) ? 1 : 0; if (g.latent_only) g.M = 8192;
    if (s == 7) { g.A = MIX; g.Bt = Wout; g.lda = 2048; g.S = 1; g.nt0 = 32; g.nt1 = 32; }
    else { g.A = ACT; g.Bt = (s == 1) ? Wfout : Wfout + (size_t)2048 * 5504; g.lda = 5504; g.S = 2; g.nt0 = 44; g.nt1 = 42; }
    StaticOrder S; S.init(g, gridDim.x, blockIdx.x);
    EpiF32 E; E.C = Y; E.ldc = 2048; E.part_stride = (size_t)NROW * DM;
    gemm_phase(tid512, lds, g, S, E);
    if (l == 0 && s == 1) { fl_slot = 1; fl_lo = 7360; fl_hi = 11660; }
    else if (l == 0 && s == 7) { fl_slot = 2; fl_lo = 11660; fl_hi = 19360; }
    else if (l == 0 && s == 10) { fl_slot = 4; fl_lo = 27760; fl_hi = 32060; }
  } else if (s == 3) {
    Gemm g; g.A = U; g.Bt = Win; g.M = NROW; g.N = 7168; g.lda = 2048; g.S = 1; g.nt0 = 32; g.nt1 = 32; g.latent_only = 0;
    StaticOrder S; S.init(g, gridDim.x, blockIdx.x);
    EpiZin E; E.z = reinterpret_cast<float*>(p.ws + OFF_Z);
    E.qc = reinterpret_cast<bfu*>(p.ws + OFF_QC); E.kc = reinterpret_cast<bfu*>(p.ws + OFF_KC); E.vt = reinterpret_cast<bfu*>(p.ws + OFF_VT);
    E.rope = reinterpret_cast<const float*>(p.ws + OFF_ROPE);
    E.lb_logits = p.lb_logits; E.layer = l;
    gemm_phase(tid512, lds, g, S, E);
  } else if (s == 4) {
    phase_m1(tid512, smem, p, l);
  } else if (s == 5) {
    phase_m2(cx, p);
  } else if (s == 6) {
    phase_m3(tid512, smem, p, l);
  }
  if (fl_hi > fl_lo) filler(tid512, smem, p, fl_slot, fl_lo, fl_hi);
}

__global__ void __launch_bounds__(512, 2) fwd_megakernel(Params p, int ph_lo, int ph_hi) {
  extern __shared__ __attribute__((aligned(16))) char smem[];
  cg::grid_group grid = cg::this_grid();
  volatile LAS unsigned* st = (volatile LAS unsigned*)((LAS unsigned char*)smem + 131072);
  if (threadIdx.x == 0) { st[0] = 0u; st[1] = 0u; st[2] = 0u; st[3] = 0u; }
  __syncthreads();
  XcdBarrier xb = xcd_barrier_post(reinterpret_cast<unsigned*>(p.ws + OFF_BAR), st);
#pragma unroll 1
  for (int ph = ph_lo; ph <= ph_hi; ++ph) {
    int tid512 = (int)__builtin_amdgcn_workitem_id_x();
    asm volatile("" : "+v"(tid512));
    run_phase(tid512, p, ph);
    if (ph < ph_hi) {
      if (ph == 0) grid.sync();
      else xcd_barrier(xb);
    }
  }
}

extern "C" void kernel_launch(void* const* d_in, const int* in_sizes, int n_in, void* d_out, int out_size, void* d_ws, size_t ws_size,
                              hipStream_t stream) {
  constexpr size_t kDynLds = 131072 + 16;
  static int grid_blocks = 0;
  if (!grid_blocks) {
    int dev = 0, cus = 0, per_cu = 0;
    (void)hipGetDevice(&dev);
    (void)hipDeviceGetAttribute(&cus, hipDeviceAttributeMultiprocessorCount, dev);
    (void)hipFuncSetAttribute((const void*)fwd_megakernel, hipFuncAttributeMaxDynamicSharedMemorySize, (int)kDynLds);
    (void)hipOccupancyMaxActiveBlocksPerMultiprocessor(&per_cu, fwd_megakernel, 512, kDynLds);
    if (per_cu < 1) per_cu = 1;
    per_cu = 1;
    grid_blocks = cus * per_cu;
  }
  if (ws_size < WS_NEED) fprintf(stderr, "workspace too small: %zu < %zu\n", ws_size, (size_t)WS_NEED);
  Params p{};
  const float** pp = reinterpret_cast<const float**>(&p);
  for (int i = 0; i < 24; ++i) pp[i] = (const float*)d_in[i];
  p.out = (float*)d_out;
  p.ws = (char*)d_ws;
  (void)hipMemsetAsync((char*)d_ws + OFF_BAR, 0, 16384, stream);
  int lo = 0, hi = N_PHASES - 1;
  void* args[] = {&p, &lo, &hi};
  hipError_t err = hipLaunchCooperativeKernel((const void*)fwd_megakernel, dim3(grid_blocks), dim3(512), args, kDynLds, stream);
  if (err != hipSuccess) fprintf(stderr, "cooperative launch failed: %s (grid %d)\n", hipGetErrorString(err), grid_blocks);
}
```
